# Optimizing an MI355X kernel written in HIP

```python
import jax, jax.numpy as jnp
from jax import lax
import numpy as np

D_MODEL = 1024
BATCH = 8
SEQ = 2048
DEPTH = 4

N_REC_LAYERS = (DEPTH + 1) // 2
N_ATT_LAYERS = DEPTH // 2
D_A = D_MODEL // 2
A_HEADS = 4
A_BLOCK = D_A // A_HEADS
CONV_WIDTH = 4
CONV_PAD = (2, 1)
RGLRU_C = 8.0
D_B = D_MODEL // 2
B_HEADS = 4
B_DK = D_B // B_HEADS
B_DV = D_B // B_HEADS
CHUNK = 32
REC_IN = 2 * D_A + 5 * D_B
REC_SPLITS = (D_A, 2 * D_A, 2 * D_A + D_B, 2 * D_A + 2 * D_B, 2 * D_A + 3 * D_B, 2 * D_A + 4 * D_B)
HEAD_DIM = 64
N_Q_HEADS = D_MODEL // HEAD_DIM
N_KV_HEADS = 4
GROUP = N_Q_HEADS // N_KV_HEADS
WINDOW = 128
QBLOCK = 128
ROPE_THETA = 10000.0
QKV_OUT = (N_Q_HEADS + 2 * N_KV_HEADS) * HEAD_DIM
D_FF = 4 * D_MODEL
EPS = 1e-6

kernel_name = "hybrid_rglru_hgrn2_swa_encoder"


def rmsnorm(x, g):
    xf = x.astype(jnp.float32)
    y = xf * lax.rsqrt(jnp.mean(xf * xf, axis=-1, keepdims=True) + EPS) * g.astype(jnp.float32)
    return y.astype(x.dtype)


def dwconv(x, w, b):
    y = lax.conv_general_dilated(x, w[:, None, :].astype(x.dtype), window_strides=(1,),
                                 padding=[CONV_PAD], dimension_numbers=('NWC', 'WIO', 'NWC'),
                                 feature_group_count=x.shape[-1])
    return y + b.astype(x.dtype)


def block_diag(x, w, b):
    xh = x.reshape(x.shape[:-1] + (A_HEADS, A_BLOCK))
    return jnp.einsum('bshi,hij->bshj', xh, w.astype(jnp.float32)).reshape(x.shape) + b.astype(jnp.float32)


def rglru(xc, w_r, b_r, w_i, b_i, lam, reverse):
    r = jax.nn.sigmoid(block_diag(xc, w_r, b_r))
    i = jax.nn.sigmoid(block_diag(xc, w_i, b_i))
    log_a = -RGLRU_C * r * jax.nn.softplus(-lam.astype(jnp.float32))
    a = jnp.exp(log_a)
    u = jnp.sqrt(-jnp.expm1(2.0 * log_a)) * (i * xc)

    def combine(left, right):
        a1, b1 = left
        a2, b2 = right
        return a1 * a2, a2 * b1 + b2

    _, h = lax.associative_scan(combine, (a, u), axis=1, reverse=reverse)
    return h


def hgrn2_direction(q, log_f, v):
    bsz, s = q.shape[:2]
    n = s // CHUNK

    def chunks(t):
        return t.reshape(bsz, n, CHUNK, B_HEADS, t.shape[-1]).transpose(0, 3, 1, 2, 4)

    q, log_f, v = chunks(q), chunks(log_f), chunks(v)
    k = -jnp.expm1(log_f)
    bcum = jnp.cumsum(log_f, axis=3)
    b_last = bcum[:, :, :, -1:, :]
    qe = q * jnp.exp(bcum)
    ke = k * jnp.exp(-bcum)
    tri = jnp.tril(jnp.ones((CHUNK, CHUNK), dtype=bool))
    att = jnp.where(tri, jnp.einsum('bhncd,bhned->bhnce', qe, ke), 0.0)
    o = jnp.einsum('bhnce,bhnev->bhncv', att, v)
    kd = k * jnp.exp(b_last - bcum)
    upd = jnp.einsum('bhncd,bhncv->nbhdv', kd, v)
    dec = jnp.exp(b_last[:, :, :, 0, :]).transpose(2, 0, 1, 3)

    def step(state, inp):
        d, u = inp
        return d[..., None] * state + u, state

    init = jnp.zeros((bsz, B_HEADS, B_DK, B_DV), q.dtype)
    _, s_prev = lax.scan(step, init, (dec, upd))
    o = o + jnp.einsum('bhncd,nbhdv->bhncv', qe, s_prev)
    return o.transpose(0, 2, 3, 1, 4).reshape(bsz, s, B_HEADS, B_DV)


def rec_mixer(u, w_in, conv_w, conv_b, w_r, b_r, w_i, b_i, lam, lb, norm_g, w_out):
    bsz, s, _ = u.shape
    proj = u @ w_in
    xa, ga, q, zf, zb, iv, g = jnp.split(proj, REC_SPLITS, axis=-1)
    xc = dwconv(xa, conv_w, conv_b).astype(jnp.float32)
    y_rec = (rglru(xc, w_r[0], b_r[0], w_i[0], b_i[0], lam[0], False)
             + rglru(xc, w_r[1], b_r[1], w_i[1], b_i[1], lam[1], True))
    y_a = jax.nn.gelu(ga.astype(jnp.float32)) * y_rec
    heads = lambda t: t.astype(jnp.float32).reshape(bsz, s, B_HEADS, -1)
    lbf = lb.astype(jnp.float32)
    log_ff = jnp.log(lbf[0] + (1.0 - lbf[0]) * jax.nn.sigmoid(zf.astype(jnp.float32)))
    log_fb = jnp.log(lbf[1] + (1.0 - lbf[1]) * jax.nn.sigmoid(zb.astype(jnp.float32)))
    qh, vh = heads(q), heads(iv)
    flip = lambda t: jnp.flip(t, axis=1)
    o = (hgrn2_direction(qh, heads(log_ff), vh)
         + flip(hgrn2_direction(flip(qh), flip(heads(log_fb)), flip(vh))))
    o = o * lax.rsqrt(jnp.mean(o * o, axis=-1, keepdims=True) + EPS)
    o = o * norm_g.astype(jnp.float32).reshape(B_HEADS, B_DV)
    y_b = o.reshape(bsz, s, D_B) * jax.nn.silu(g.astype(jnp.float32))
    y = jnp.concatenate([y_a, y_b], axis=-1).astype(u.dtype)
    return y @ w_out


def rope(t, cos, sin):
    half = t.shape[-1] // 2
    t1, t2 = t[..., :half], t[..., half:]
    return jnp.concatenate([t1 * cos - t2 * sin, t2 * cos + t1 * sin], axis=-1)


def window_attention(u, w_qkv, sinks, w_o, cos, sin, band_mask):
    bsz, s, _ = u.shape
    nb = s // QBLOCK
    qkv = u @ w_qkv
    q, k, v = jnp.split(qkv, (N_Q_HEADS * HEAD_DIM, (N_Q_HEADS + N_KV_HEADS) * HEAD_DIM), axis=-1)
    q = rope(q.reshape(bsz, s, N_Q_HEADS, HEAD_DIM), cos, sin)
    k = rope(k.reshape(bsz, s, N_KV_HEADS, HEAD_DIM), cos, sin)
    v = v.reshape(bsz, s, N_KV_HEADS, HEAD_DIM)

    def band(t):
        tp = jnp.pad(t, ((0, 0), (QBLOCK, QBLOCK), (0, 0), (0, 0)))
        tp = tp.reshape(bsz, nb + 2, QBLOCK, N_KV_HEADS, HEAD_DIM)
        return jnp.concatenate([tp[:, :-2], tp[:, 1:-1], tp[:, 2:]], axis=2)

    kb, vb = band(k), band(v)
    qb = q.reshape(bsz, nb, QBLOCK, N_KV_HEADS, GROUP, HEAD_DIM)
    sc = jnp.einsum('bnqhgd,bnkhd->bnhgqk', qb, kb).astype(jnp.float32) * (HEAD_DIM ** -0.5)
    sc = jnp.where(band_mask[None, :, None, None], sc, -jnp.inf)
    sink = jnp.broadcast_to(sinks.astype(jnp.float32).reshape(1, 1, N_KV_HEADS, GROUP, 1, 1),
                            sc.shape[:-1] + (1,))
    p = jax.nn.softmax(jnp.concatenate([sc, sink], axis=-1), axis=-1)[..., :-1]
    o = jnp.einsum('bnhgqk,bnkhd->bnqhgd', p.astype(vb.dtype), vb)
    return o.reshape(bsz, s, N_Q_HEADS * HEAD_DIM) @ w_o


def sqrelu_mlp(u, w1, w2):
    hdn = jnp.square(jax.nn.relu(u @ w1))
    return hdn @ w2


def setup_inputs(seed: int = 0) -> dict:
    key = jax.random.key(seed)
    ks = jax.random.split(key, 20)
    nrm = lambda k, shape, scale: jax.random.normal(k, shape, jnp.float32) * scale
    u = jax.random.uniform(ks[10], (N_REC_LAYERS, 2, D_A), jnp.float32, 0.9, 0.999)
    a0 = u ** (1.0 / RGLRU_C)
    rg_lambda = jnp.log(a0) - jnp.log1p(-a0)
    return {
        "x": nrm(ks[0], (BATCH, SEQ, D_MODEL), 1.0),
        "norm_g": 1.0 + nrm(ks[1], (DEPTH, 4, D_MODEL), 0.02),
        "rec_w_in": nrm(ks[2], (N_REC_LAYERS, D_MODEL, REC_IN), D_MODEL ** -0.5),
        "rec_conv_w": nrm(ks[3], (N_REC_LAYERS, CONV_WIDTH, D_A), CONV_WIDTH ** -0.5),
        "rec_conv_b": nrm(ks[4], (N_REC_LAYERS, D_A), 0.01),
        "rg_w_r": nrm(ks[5], (N_REC_LAYERS, 2, A_HEADS, A_BLOCK, A_BLOCK), A_BLOCK ** -0.5),
        "rg_b_r": nrm(ks[6], (N_REC_LAYERS, 2, D_A), 0.01),
        "rg_w_i": nrm(ks[7], (N_REC_LAYERS, 2, A_HEADS, A_BLOCK, A_BLOCK), A_BLOCK ** -0.5),
        "rg_b_i": nrm(ks[8], (N_REC_LAYERS, 2, D_A), 0.01),
        "rg_lambda": rg_lambda,
        "hgrn_lb_logits": nrm(ks[11], (2, N_REC_LAYERS, D_B), 0.5),
        "hgrn_norm_g": 1.0 + nrm(ks[12], (N_REC_LAYERS, D_B), 0.02),
        "rec_w_out": nrm(ks[13], (N_REC_LAYERS, D_A + D_B, D_MODEL), (D_A + D_B) ** -0.5),
        "att_w_qkv": nrm(ks[14], (N_ATT_LAYERS, D_MODEL, QKV_OUT), D_MODEL ** -0.5),
        "att_sinks": nrm(ks[15], (N_ATT_LAYERS, N_Q_HEADS), 0.5),
        "att_w_o": nrm(ks[16], (N_ATT_LAYERS, N_Q_HEADS * HEAD_DIM, D_MODEL), (N_Q_HEADS * HEAD_DIM) ** -0.5),
        "mlp_w1": nrm(ks[17], (DEPTH, D_MODEL, D_FF), D_MODEL ** -0.5),
        "mlp_w2": nrm(ks[18], (DEPTH, D_FF, D_MODEL), D_FF ** -0.5),
    }


def reference(x, norm_g, rec_w_in, rec_conv_w, rec_conv_b, rg_w_r, rg_b_r, rg_w_i, rg_b_i,
              rg_lambda, hgrn_lb_logits, hgrn_norm_g, rec_w_out, att_w_qkv, att_sinks, att_w_o,
              mlp_w1, mlp_w2):
    s = x.shape[1]
    nb = s // QBLOCK
    pos = jnp.arange(s, dtype=jnp.float32)
    inv_freq = ROPE_THETA ** (-jnp.arange(0, HEAD_DIM, 2, dtype=jnp.float32) / HEAD_DIM)
    ang = pos[:, None] * inv_freq[None, :]
    cos = jnp.cos(ang)[:, None, :].astype(x.dtype)
    sin = jnp.sin(ang)[:, None, :].astype(x.dtype)
    qpos = jnp.arange(nb)[:, None, None] * QBLOCK + jnp.arange(QBLOCK)[None, :, None]
    kpos = (jnp.arange(nb)[:, None, None] - 1) * QBLOCK + jnp.arange(3 * QBLOCK)[None, None, :]
    band_mask = (jnp.abs(qpos - kpos) <= WINDOW) & (kpos >= 0) & (kpos < s)
    s_lb = jax.nn.softmax(hgrn_lb_logits.astype(jnp.float32), axis=1)
    lbs = jnp.cumsum(s_lb, axis=1) - s_lb[:, :1]

    h = x
    for layer in range(DEPTH):
        g = norm_g[layer]
        un = rmsnorm(h, g[0])
        if layer % 2 == 0:
            r = layer // 2
            m = rec_mixer(un, rec_w_in[r], rec_conv_w[r], rec_conv_b[r], rg_w_r[r], rg_b_r[r],
                          rg_w_i[r], rg_b_i[r], rg_lambda[r], lbs[:, r], hgrn_norm_g[r], rec_w_out[r])
        else:
            a = layer // 2
            m = window_attention(un, att_w_qkv[a], att_sinks[a], att_w_o[a], cos, sin, band_mask)
        h = h + rmsnorm(m.astype(h.dtype), g[1])
        m = sqrelu_mlp(rmsnorm(h, g[2]), mlp_w1[layer], mlp_w2[layer])
        h = h + rmsnorm(m.astype(h.dtype), g[3])
    return h
```

```cpp
#include <hip/hip_runtime.h>
#include <hip/hip_cooperative_groups.h>
#include <cstdio>
namespace cg = cooperative_groups;
namespace pg8 {
#define PG8_LAS __attribute__((address_space(3)))
typedef unsigned short bf16_t;
typedef short bf16x8 __attribute__((ext_vector_type(8)));
typedef float f32x4 __attribute__((ext_vector_type(4)));
typedef unsigned u32x4 __attribute__((ext_vector_type(4)));
constexpr int BM = 256, BK = 64, HALF = 128, HTB = HALF * BK * 2  , STAGE_BYTES = 8 * HTB, NXCD = 8, WGM = 8;

__host__ __device__ __forceinline__ int lds_byte(int r, int c) { const int st = (r >> 4) * 2 + (c >> 5), rr = r & 15, cc = c & 31, ob = rr * 64 + cc * 2; return st * 1024 + (ob ^ (((ob >> 9) & 1) << 5)); }
__host__ __device__ __forceinline__ void stage_rc(int b, int& R, int& C) { const int st = b / 1024, sb = b % 1024, swz = sb ^ (((sb >> 9) & 1) << 5); R = (st >> 1) * 16 + swz / 64; C = (st & 1) * 32 + (swz % 64) / 2; }
__host__ __device__ __forceinline__ int perm32(int rho) { const int n = rho >> 4, i = rho & 15; return 8 * (i >> 2) + 4 * n + (i & 3); }

struct Unit { int pm, pn; };
struct Gemm { const bf16_t* A; const bf16_t* Bt; int M, N, K; };

struct StaticOrder {
    int nM, nN, nwg, G, c;
    __host__ __device__ void init(int M, int N, int G_, int c_) { nM = M / BM; nN = N / BM; nwg = nM * nN; G = G_; c = c_; }
    __host__ __device__ bool next(int i, Unit& u) const {
        const long L = (long)i * G + c; if (L >= nwg) return false;
        int wgid = (int)L; { const int q = nwg / NXCD, r = nwg % NXCD, xcd = wgid % NXCD, off = wgid / NXCD; wgid = (xcd < r ? xcd * (q + 1) : r * (q + 1) + (xcd - r) * q) + off; }
        const int nig = WGM * nN, gid = wgid / nig, fm = gid * WGM, gsz = (nM - fm) < WGM ? (nM - fm) : WGM;
        u.pm = fm + ((wgid % nig) % gsz); u.pn = (wgid % nig) / gsz; return true;
    }
    __device__ __forceinline__ void a_ready(const Unit&) const {}
    __device__ __forceinline__ void done(const Unit&) const {}
};

template <class Epi, class Sched, bool STAMP = false>
__device__ __forceinline__ void gemm_phase(PG8_LAS unsigned char* lds, const Gemm g, const Sched& S, const Epi& E, unsigned long long* stamps = nullptr) {
    int tid = threadIdx.x; asm volatile("" : "+v"(tid)); const int wid = __builtin_amdgcn_readfirstlane(tid >> 6), lane = tid & 63, wr = wid >> 2, wc = wid & 3, fr = lane & 15, fq = lane >> 4;
    const int K = g.K, nt = K / BK;
    int ts_lo = 0, ts_hi = 0, nts = 0; const unsigned long long rt_entry = STAMP ? (unsigned long long)wall_clock64() : 0ull;
#define PG8_STAMP() do { if (STAMP && wid == 0 && nts < 64) { const unsigned long long _c = (unsigned long long)clock64(); \
        ts_lo = (lane == nts) ? (int)(unsigned)_c : ts_lo; ts_hi = (lane == nts) ? (int)(unsigned)(_c >> 32) : ts_hi; ++nts; } } while (0)
    PG8_STAMP();
    unsigned voffA[2], voffB[2];
#pragma unroll
    for (int i = 0; i < 2; ++i) { int R, C; stage_rc(tid * 16 + i * 8192, R, C); const int Rb = Epi::PERM ? ((R & ~31) + perm32(R & 31)) : R;
        voffA[i] = (unsigned)(R * K + C) * 2u; voffB[i] = (unsigned)(Rb * K + C) * 2u; }
    const size_t kstep = (size_t)(BK * 2);
    const size_t hstep = (size_t)HALF * K * 2;
    const size_t tstep = 2 * hstep;
    const unsigned ldsw = (unsigned)wid * 1024u;
    const int aoff = lds_byte(wr * 64 + fr, fq * 8), boff = lds_byte(wc * 32 + fr, fq * 8);
#define PG8_SA(b, h) (((b) * 2 + (h)) * HTB)
#define PG8_SB(b, h) ((4 + (b) * 2 + (h)) * HTB)
#define PG8_STAGE(bufoff, gbase, voff) do { _Pragma("unroll") for (int _i = 0; _i < 2; ++_i) \
        __builtin_amdgcn_global_load_lds((const unsigned*)((const char*)(gbase) + (voff)[_i]), (PG8_LAS unsigned*)(lds + (bufoff) + ldsw + _i * 8192), 16, 0, 0); } while (0)
#define PG8_LDA(dst, b, h) do { _Pragma("unroll") for (int m = 0; m < 4; ++m) _Pragma("unroll") for (int k = 0; k < 2; ++k) dst[m][k] = *(const PG8_LAS bf16x8*)(lds + PG8_SA(b, h) + aoff + m * 2048 + k * 1024); } while (0)
#define PG8_LDB(dst, b, h) do { _Pragma("unroll") for (int n = 0; n < 2; ++n) _Pragma("unroll") for (int k = 0; k < 2; ++k) dst[n][k] = *(const PG8_LAS bf16x8*)(lds + PG8_SB(b, h) + boff + n * 2048 + k * 1024); } while (0)
#define PG8_MMA(ai, bj, At, Bt) do { __builtin_amdgcn_s_setprio(1); _Pragma("unroll") for (int m = 0; m < 4; ++m) _Pragma("unroll") for (int n = 0; n < 2; ++n) _Pragma("unroll") for (int k = 0; k < 2; ++k) \
        acc[ai][bj][m][n] = __builtin_amdgcn_mfma_f32_16x16x32_bf16(Bt[n][k], At[m][k], acc[ai][bj][m][n], 0, 0, 0); __builtin_amdgcn_s_setprio(0); } while (0)
#define PG8_WAIT_V(n) asm volatile("s_waitcnt vmcnt(" #n ")" ::: "memory")
#define PG8_WAIT_L(n) asm volatile("s_waitcnt lgkmcnt(" #n ")" ::: "memory")
#define PG8_BAR __builtin_amdgcn_s_barrier()
#define PG8_SCHED __builtin_amdgcn_sched_barrier(0)
    Unit cur, nxt; int ui = 0;
    if (!S.next(0, cur)) return;
    f32x4 acc[2][2][4][2];
#pragma unroll
    for (int a = 0; a < 2; ++a)
#pragma unroll
        for (int b = 0; b < 2; ++b)
#pragma unroll
            for (int m = 0; m < 4; ++m)
#pragma unroll
                for (int n = 0; n < 2; ++n) acc[a][b][m][n] = (f32x4){0.f, 0.f, 0.f, 0.f};
    bf16x8 At[4][2], B0[2][2], B1[2][2];
    const char* cA = (const char*)g.A + (size_t)cur.pm * tstep; const char* cB = (const char*)g.Bt + (size_t)cur.pn * tstep;
    S.a_ready(cur);
    PG8_STAGE(PG8_SB(0, 0), cB, voffB); PG8_STAGE(PG8_SA(0, 0), cA, voffA); PG8_STAGE(PG8_SB(0, 1), cB + hstep, voffB); PG8_STAGE(PG8_SA(0, 1), cA + hstep, voffA);
    if (wr == 1) PG8_BAR;
    PG8_WAIT_V(4); PG8_BAR;
    PG8_STAGE(PG8_SB(1, 0), cB + kstep, voffB); PG8_STAGE(PG8_SA(1, 0), cA + kstep, voffA); PG8_STAGE(PG8_SB(1, 1), cB + hstep + kstep, voffB);
    PG8_WAIT_V(6); PG8_BAR;
    PG8_STAMP();
    for (;;) {
        const bool has_next = S.next(ui + 1, nxt);
        const char* nA = has_next ? (const char*)g.A + (size_t)nxt.pm * tstep : cA; const char* nB = has_next ? (const char*)g.Bt + (size_t)nxt.pn * tstep : cB;
        for (int t = 0; t < nt; t += 2) {
            const bool last = (t == nt - 2);
            const char* a1 = cA + (size_t)(t + 1) * kstep;
            const char* a2 = last ? nA : cA + (size_t)(t + 2) * kstep; const char* b2 = last ? nB : cB + (size_t)(t + 2) * kstep;
            const char* a3 = a2 + kstep; const char* b3 = b2 + kstep;
            if (last && has_next) S.a_ready(nxt);
            PG8_LDB(B0, 0, 0); PG8_SCHED; PG8_LDA(At, 0, 0); PG8_STAGE(PG8_SA(1, 1), a1 + hstep, voffA);
            PG8_WAIT_L(8); PG8_BAR; PG8_WAIT_L(0); PG8_MMA(0, 0, At, B0); PG8_BAR; PG8_SCHED;
            PG8_LDB(B1, 0, 1); PG8_STAGE(PG8_SB(0, 0), b2, voffB);
            PG8_BAR; PG8_WAIT_L(0); PG8_MMA(0, 1, At, B1); PG8_BAR;
            PG8_LDA(At, 0, 1); PG8_STAGE(PG8_SA(0, 0), a2, voffA);
            PG8_BAR; PG8_WAIT_L(0); PG8_MMA(1, 0, At, B0); PG8_BAR; PG8_SCHED;
            PG8_STAGE(PG8_SB(0, 1), b2 + hstep, voffB);
            PG8_WAIT_V(6); PG8_BAR; PG8_MMA(1, 1, At, B1); PG8_BAR;
            PG8_LDB(B0, 1, 0); PG8_SCHED; PG8_LDA(At, 1, 0); PG8_STAGE(PG8_SA(0, 1), a2 + hstep, voffA);
            PG8_WAIT_L(8); PG8_BAR; PG8_WAIT_L(0); PG8_MMA(0, 0, At, B0); PG8_BAR; PG8_SCHED;
            PG8_LDB(B1, 1, 1); PG8_STAGE(PG8_SB(1, 0), b3, voffB);
            PG8_BAR; PG8_WAIT_L(0); PG8_MMA(0, 1, At, B1); PG8_BAR;
            PG8_LDA(At, 1, 1); PG8_STAGE(PG8_SA(1, 0), a3, voffA);
            PG8_BAR; PG8_WAIT_L(0); PG8_MMA(1, 0, At, B0); PG8_BAR; PG8_SCHED;
            PG8_STAGE(PG8_SB(1, 1), b3 + hstep, voffB);
            PG8_WAIT_V(6); PG8_BAR; PG8_MMA(1, 1, At, B1); PG8_BAR;
        }
        PG8_STAMP();
        if constexpr (!Epi::AFTER_DRAIN) { E(acc, cur, wr, wc, fr, fq); S.done(cur); }
        PG8_STAMP();
        if (!has_next) break;
#pragma unroll
        for (int a = 0; a < 2; ++a)
#pragma unroll
            for (int b = 0; b < 2; ++b)
#pragma unroll
                for (int m = 0; m < 4; ++m)
#pragma unroll
                    for (int n = 0; n < 2; ++n) acc[a][b][m][n] = (f32x4){0.f, 0.f, 0.f, 0.f};
        cur = nxt; cA = nA; cB = nB; ++ui;
    }
    PG8_WAIT_V(0);
    if (wr == 0) PG8_BAR;
    PG8_BAR;
    if constexpr (Epi::AFTER_DRAIN) { E.fused(acc, cur, wr, wc, fr, fq, lds, wid, lane); S.done(cur); }
    PG8_STAMP();
    if (STAMP && wid == 0) { stamps[lane] = lane < nts ? (((unsigned long long)(unsigned)ts_hi << 32) | (unsigned)ts_lo) : 0ull;
        if (lane == 62) stamps[62] = rt_entry; if (lane == 63) stamps[63] = (unsigned long long)wall_clock64(); }
#undef PG8_STAMP
#undef PG8_SA
#undef PG8_SB
#undef PG8_STAGE
#undef PG8_LDA
#undef PG8_LDB
#undef PG8_MMA
#undef PG8_WAIT_V
#undef PG8_WAIT_L
#undef PG8_BAR
#undef PG8_SCHED
}
}


using pg8::bf16_t; using pg8::bf16x8; using pg8::f32x4; using pg8::u32x4;
typedef unsigned u32x2 __attribute__((ext_vector_type(2)));
#define DI __device__ __forceinline__
#define MFMA16(a, b, c) __builtin_amdgcn_mfma_f32_16x16x32_bf16((a), (b), (c), 0, 0, 0)

constexpr int MT = 16384, DM = 1024, SEQ = 2048;
constexpr int LDS_BYTES = 147456;
constexpr float EPSF = 1e-6f;

constexpr size_t WS_WA = 0;
constexpr size_t WS_WB = WS_WA + 7340032;
constexpr size_t WS_WG = WS_WB + 2097152;
constexpr size_t WS_W1 = WS_WG + 524288;
constexpr size_t WS_W2 = WS_W1 + 8388608;
constexpr size_t WS_HB = WS_W2 + 8388608;
constexpr size_t WS_M  = WS_HB + 33554432;
constexpr size_t WS_RS = WS_M + 33554432;
constexpr size_t WS_ROPE = WS_RS + 65536;
constexpr size_t WS_LB = WS_ROPE + 524288;
constexpr size_t WS_AGG = WS_LB + 65536;
constexpr size_t WS_BIG = WS_AGG + 4194304;
constexpr size_t WS_PF = WS_BIG + 83886080;
constexpr size_t WS_END = WS_PF + 67108864;

struct Prm {
    const float* x; const float* norm_g; const float* rec_w_in; const float* rec_conv_w; const float* rec_conv_b;
    const float* rg_w_r; const float* rg_b_r; const float* rg_w_i; const float* rg_b_i; const float* rg_lambda;
    const float* lb_logits; const float* hgrn_norm_g; const float* rec_w_out; const float* att_w_qkv; const float* att_sinks;
    const float* att_w_o; const float* mlp_w1; const float* mlp_w2;
    float* out; unsigned char* ws;
};

DI int tid_now() { int t = threadIdx.x; asm volatile("" : "+v"(t)); return t; }
DI int bid_now() { int t = blockIdx.x; asm volatile("" : "+s"(t)); return t; }
DI bf16_t f2bf(float f) { unsigned u = __float_as_uint(f); u += 0x7fffu + ((u >> 16) & 1u); return (bf16_t)(u >> 16); }
DI float bf2f(bf16_t b) { return __uint_as_float(((unsigned)b) << 16); }
DI unsigned pk2(float lo, float hi) { return (unsigned)f2bf(lo) | ((unsigned)f2bf(hi) << 16); }
DI float bflo(unsigned u) { return __uint_as_float(u << 16); }
DI float bfhi(unsigned u) { return __uint_as_float(u & 0xffff0000u); }
DI float sigm(float x) { return 1.0f / (1.0f + __expf(-x)); }
DI float wave_sum(float v) { for (int o = 32; o > 0; o >>= 1) v += __shfl_xor(v, o); return v; }

struct Epi {
    static constexpr bool PERM = false, AFTER_DRAIN = false;
    int mode; bf16_t* O; int ldc; const float* rs; float* Pf; const float* lbv;
    DI void operator()(const f32x4 (&acc)[2][2][4][2], const pg8::Unit& u, int wr, int wc, int fr, int fq) const {
        const int row0 = u.pm * 256 + wr * 64 + fr, col0 = u.pn * 256 + wc * 32 + 4 * fq;
        const int ctile = u.pn * 256;
        const bool tof32 = (mode == 3) && (ctile >= 1536) && (ctile < 2560);
        const int cshift = (mode == 3) ? (ctile < 1536 ? 0 : (tof32 ? -1536 : -1024)) : 0;
#pragma unroll
        for (int ai = 0; ai < 2; ++ai)
#pragma unroll
            for (int m = 0; m < 4; ++m) {
                const int row = row0 + ai * 128 + m * 16;
                const float s = (mode != 0) ? rs[row] : 1.0f;
#pragma unroll
                for (int bj = 0; bj < 2; ++bj)
#pragma unroll
                    for (int n = 0; n < 2; ++n) {
                        f32x4 v = acc[ai][bj][m][n] * s;
                        const int col = col0 + bj * 128 + n * 16 + cshift;
                        if (tof32) {
                            f32x4 lb = *(const f32x4*)(lbv + col);
                            f32x4 o;
#pragma unroll
                            for (int j = 0; j < 4; ++j) o[j] = logf(lb[j] + (1.0f - lb[j]) * sigm(v[j]));
                            *(f32x4*)(Pf + (size_t)row * 1024 + col) = o;
                        } else {
                            if (mode == 2) {
#pragma unroll
                                for (int j = 0; j < 4; ++j) { float t = fmaxf(v[j], 0.f); v[j] = t * t; }
                            }
                            u32x2 w; w.x = pk2(v[0], v[1]); w.y = pk2(v[2], v[3]);
                            *(u32x2*)(O + (size_t)row * ldc + col) = w;
                        }
                    }
            }
    }
};

DI void conv_wt(const float* __restrict__ src, bf16_t* __restrict__ dst, int K, int N, const float* __restrict__ g, float* tile) {
    const int tid = tid_now();
    const int tn = N / 64, tk = K / 64, nt = tn * tk;
    for (int t = blockIdx.x; t < nt; t += gridDim.x) {
        const int k0 = (t / tn) * 64, n0 = (t % tn) * 64;
        { const int n = tid & 63, kk = tid >> 6;
#pragma unroll
          for (int i = 0; i < 8; ++i) { const int k = kk + 8 * i; float v = src[(size_t)(k0 + k) * N + n0 + n]; if (g) v *= g[k0 + k]; tile[k * 65 + n] = v; } }
        __syncthreads();
        { const int k = tid & 63, nn = tid >> 6;
#pragma unroll
          for (int i = 0; i < 8; ++i) { const int n = nn + 8 * i; dst[(size_t)(n0 + n) * K + k0 + k] = f2bf(tile[k * 65 + n]); } }
        __syncthreads();
    }
}
DI void conv_gates(const float* __restrict__ w_r, const float* __restrict__ w_i, bf16_t* __restrict__ dst) {
    for (int idx = blockIdx.x * 512 + tid_now(); idx < 4 * 512 * 128; idx += gridDim.x * 512) {
        const int k = idx & 127, np = (idx >> 7) & 511, h = idx >> 16;
        const int w = np >> 6, ct = (np >> 4) & 3, jj = np & 15;
        const int dir = w >> 2, gate = ct >> 1, j = (w & 3) * 32 + (ct & 1) * 16 + jj;
        const float* s = gate ? w_i : w_r;
        dst[idx] = f2bf(s[((dir * 4 + h) * 128 + k) * 128 + j]);
    }
}
DI void conv_layer(const Prm& P, int layer, unsigned char* lds) {
    float* tile = (float*)lds;
    unsigned char* ws = P.ws;
    const float* g = P.norm_g + (size_t)layer * 4096;
    if ((layer & 1) == 0) {
        const int r = layer >> 1;
        conv_wt(P.rec_w_in + (size_t)r * 1024 * 3584, (bf16_t*)(ws + WS_WA), 1024, 3584, g, tile);
        conv_wt(P.rec_w_out + (size_t)r * 1024 * 1024, (bf16_t*)(ws + WS_WB), 1024, 1024, nullptr, tile);
        conv_gates(P.rg_w_r + (size_t)r * 131072, P.rg_w_i + (size_t)r * 131072, (bf16_t*)(ws + WS_WG));
    } else {
        const int a = layer >> 1;
        conv_wt(P.att_w_qkv + (size_t)a * 1024 * 1536, (bf16_t*)(ws + WS_WA), 1024, 1536, g, tile);
        conv_wt(P.att_w_o + (size_t)a * 1024 * 1024, (bf16_t*)(ws + WS_WB), 1024, 1024, nullptr, tile);
    }
    conv_wt(P.mlp_w1 + (size_t)layer * 1024 * 4096, (bf16_t*)(ws + WS_W1), 1024, 4096, g + 2048, tile);
    conv_wt(P.mlp_w2 + (size_t)layer * 4096 * 1024, (bf16_t*)(ws + WS_W2), 4096, 1024, nullptr, tile);
}

DI void resnorm_phase(const bf16_t* __restrict__ m, const float* __restrict__ h_in, float* __restrict__ h_out, bf16_t* __restrict__ hb,
                      float* __restrict__ rs, const float* __restrict__ gp) {
    const int tid_ = tid_now(); const int lane = tid_ & 63, w = tid_ >> 6;
    for (int row = blockIdx.x * 8 + w; row < MT; row += gridDim.x * 8) {
        f32x4 h[4];
#pragma unroll
        for (int i = 0; i < 4; ++i) h[i] = *(const f32x4*)(h_in + (size_t)row * 1024 + i * 256 + lane * 4);
        if (m) {
            f32x4 mv[4]; float ss = 0.f;
#pragma unroll
            for (int i = 0; i < 4; ++i) {
                u32x2 q = *(const u32x2*)(m + (size_t)row * 1024 + i * 256 + lane * 4);
                mv[i][0] = bflo(q.x); mv[i][1] = bfhi(q.x); mv[i][2] = bflo(q.y); mv[i][3] = bfhi(q.y);
                ss += mv[i][0] * mv[i][0] + mv[i][1] * mv[i][1] + mv[i][2] * mv[i][2] + mv[i][3] * mv[i][3];
            }
            ss = wave_sum(ss);
            const float rm = rsqrtf(ss * (1.0f / 1024.0f) + EPSF);
#pragma unroll
            for (int i = 0; i < 4; ++i) {
                f32x4 gv = *(const f32x4*)(gp + i * 256 + lane * 4);
                h[i] = h[i] + mv[i] * rm * gv;
                *(f32x4*)(h_out + (size_t)row * 1024 + i * 256 + lane * 4) = h[i];
            }
        }
        float s2 = 0.f;
#pragma unroll
        for (int i = 0; i < 4; ++i) {
            s2 += h[i][0] * h[i][0] + h[i][1] * h[i][1] + h[i][2] * h[i][2] + h[i][3] * h[i][3];
            u32x2 q; q.x = pk2(h[i][0], h[i][1]); q.y = pk2(h[i][2], h[i][3]);
            *(u32x2*)(hb + (size_t)row * 1024 + i * 256 + lane * 4) = q;
        }
        s2 = wave_sum(s2);
        if (lane == 0) rs[row] = rsqrtf(s2 * (1.0f / 1024.0f) + EPSF);
    }
}

DI void prep_phase(const Prm& P, unsigned char* lds) {
    unsigned char* ws = P.ws;
    float* lbv = (float*)(ws + WS_LB);
    float* rc = (float*)(ws + WS_ROPE); float* rsn = rc + 2048 * 32;
    const int gt = blockIdx.x * 512 + tid_now(), gn = gridDim.x * 512;
    for (int i = gt; i < 1024; i += gn) {
        const int d = i >> 9, c = i & 511;
        const float l0 = P.lb_logits[(d * 2 + 0) * 512 + c], l1 = P.lb_logits[(d * 2 + 1) * 512 + c];
        const float mx = fmaxf(l0, l1), e0 = expf(l0 - mx), e1 = expf(l1 - mx);
        lbv[(0 * 2 + d) * 512 + c] = 0.f;
        lbv[(1 * 2 + d) * 512 + c] = e1 / (e0 + e1);
    }
    for (int i = gt; i < 2048 * 32; i += gn) {
        const int pos = i >> 5, f = i & 31;
        const float inv = powf(10000.0f, -(float)(2 * f) / 64.0f);
        const float ang = (float)pos * inv;
        rc[i] = cosf(ang); rsn[i] = sinf(ang);
    }
    conv_layer(P, 0, lds);
    resnorm_phase(nullptr, P.x, nullptr, (bf16_t*)(ws + WS_HB), (float*)(ws + WS_RS), nullptr);
}

DI void hgrn_item(const Prm& P, int it, unsigned char* lds) {
    const int tid = tid_now(), lane = tid & 63, w = tid >> 6, r16 = lane & 15, quad = lane >> 4;
    const int dir = it & 1, h = (it >> 1) & 3, b = it >> 3;
    bf16_t* qe = (bf16_t*)lds;
    bf16_t* ke = qe + 32 * 136;
    bf16_t* kdT = ke + 32 * 136;
    bf16_t* vT = kdT + 128 * 40;
    float* dec = (float*)(vT + 128 * 40);
    float* gtot = dec + 128;
    bf16_t* attL = (bf16_t*)(gtot + 512) + w * (32 * 40);
    bf16_t* STw = (bf16_t*)(gtot + 512) + 8 * 32 * 40 + w * (16 * 136);
    const bf16_t* Pb = (const bf16_t*)(P.ws + WS_BIG);
    const float* Pf = (const float*)(P.ws + WS_PF);
    bf16_t* Od = (bf16_t*)(P.ws + WS_M) + (size_t)dir * MT * 512;
    const int ch = tid & 127, tg = tid >> 7;
    for (int i = lane; i < 16 * 136; i += 64) STw[i] = 0;
    f32x4 Sacc[8];
#pragma unroll
    for (int i = 0; i < 8; ++i) Sacc[i] = (f32x4){0.f, 0.f, 0.f, 0.f};
    float lfN[8], qN[8], vN[8];
#pragma unroll
    for (int j = 0; j < 8; ++j) {
        const int tv = tg * 8 + j, t = dir ? (SEQ - 1 - tv) : tv; const size_t row = (size_t)b * SEQ + t;
        lfN[j] = Pf[row * 1024 + dir * 512 + h * 128 + ch];
        qN[j] = bf2f(Pb[row * 2560 + 1024 + h * 128 + ch]);
        vN[j] = bf2f(Pb[row * 2560 + 1536 + h * 128 + ch]);
    }
    for (int n = 0; n < 64; ++n) {
        float lf[8], q[8], v[8], c[8];
#pragma unroll
        for (int j = 0; j < 8; ++j) { lf[j] = lfN[j]; q[j] = qN[j]; v[j] = vN[j]; }
        { float run = 0.f;
#pragma unroll
          for (int j = 0; j < 8; ++j) { run += lf[j]; c[j] = run; } }
        gtot[tg * 128 + ch] = c[7];
        __syncthreads();
        float pre = 0.f, btot = 0.f;
#pragma unroll
        for (int g = 0; g < 4; ++g) { const float x = gtot[g * 128 + ch]; btot += x; if (g < tg) pre += x; }
        { u32x4 kdp, vp;
          float kdv[8];
#pragma unroll
          for (int j = 0; j < 8; ++j) {
              const float bc = pre + c[j];
              const float k = -expm1f(lf[j]);
              const int i = tg * 8 + j;
              qe[i * 136 + ch] = f2bf(q[j] * __expf(bc));
              ke[i * 136 + ch] = f2bf(k * __expf(-bc));
              kdv[j] = k * __expf(btot - bc);
          }
          kdp.x = pk2(kdv[0], kdv[1]); kdp.y = pk2(kdv[2], kdv[3]); kdp.z = pk2(kdv[4], kdv[5]); kdp.w = pk2(kdv[6], kdv[7]);
          vp.x = pk2(v[0], v[1]); vp.y = pk2(v[2], v[3]); vp.z = pk2(v[4], v[5]); vp.w = pk2(v[6], v[7]);
          *(u32x4*)(kdT + ch * 40 + tg * 8) = kdp;
          *(u32x4*)(vT + ch * 40 + tg * 8) = vp;
          if (tg == 0) dec[ch] = __expf(btot);
        }
        if (n + 1 < 64) {
#pragma unroll
            for (int j = 0; j < 8; ++j) {
                const int tv = (n + 1) * 32 + tg * 8 + j, t = dir ? (SEQ - 1 - tv) : tv; const size_t row = (size_t)b * SEQ + t;
                lfN[j] = Pf[row * 1024 + dir * 512 + h * 128 + ch];
                qN[j] = bf2f(Pb[row * 2560 + 1024 + h * 128 + ch]);
                vN[j] = bf2f(Pb[row * 2560 + 1536 + h * 128 + ch]);
            }
        }
        __syncthreads();
        f32x4 att[2][2];
#pragma unroll
        for (int rt = 0; rt < 2; ++rt)
#pragma unroll
            for (int ct = 0; ct < 2; ++ct) att[rt][ct] = (f32x4){0.f, 0.f, 0.f, 0.f};
        bf16x8 qa[2][4];
#pragma unroll
        for (int ks = 0; ks < 4; ++ks) {
#pragma unroll
            for (int rt = 0; rt < 2; ++rt) qa[rt][ks] = *(const bf16x8*)(qe + (rt * 16 + r16) * 136 + ks * 32 + quad * 8);
#pragma unroll
            for (int ct = 0; ct < 2; ++ct) {
                const bf16x8 kb = *(const bf16x8*)(ke + (ct * 16 + r16) * 136 + ks * 32 + quad * 8);
#pragma unroll
                for (int rt = 0; rt < 2; ++rt) att[rt][ct] = MFMA16(qa[rt][ks], kb, att[rt][ct]);
            }
        }
#pragma unroll
        for (int rt = 0; rt < 2; ++rt)
#pragma unroll
            for (int ct = 0; ct < 2; ++ct)
#pragma unroll
                for (int reg = 0; reg < 4; ++reg) {
                    const int cc = rt * 16 + quad * 4 + reg, ee = ct * 16 + r16;
                    attL[cc * 40 + ee] = f2bf(cc >= ee ? att[rt][ct][reg] : 0.f);
                }
        __syncthreads();
        const bf16x8 vb = *(const bf16x8*)(vT + (16 * w + r16) * 40 + quad * 8);
        f32x4 o[2];
#pragma unroll
        for (int rt = 0; rt < 2; ++rt) {
            const bf16x8 aa = *(const bf16x8*)(attL + (rt * 16 + r16) * 40 + quad * 8);
            o[rt] = MFMA16(aa, vb, ((f32x4){0.f, 0.f, 0.f, 0.f}));
        }
#pragma unroll
        for (int ks = 0; ks < 4; ++ks) {
            const bf16x8 sb = *(const bf16x8*)(STw + r16 * 136 + ks * 32 + quad * 8);
#pragma unroll
            for (int rt = 0; rt < 2; ++rt) o[rt] = MFMA16(qa[rt][ks], sb, o[rt]);
        }
#pragma unroll
        for (int rt = 0; rt < 2; ++rt)
#pragma unroll
            for (int reg = 0; reg < 4; ++reg) {
                const int tv = n * 32 + rt * 16 + quad * 4 + reg, t = dir ? (SEQ - 1 - tv) : tv;
                Od[((size_t)b * SEQ + t) * 512 + h * 128 + 16 * w + r16] = f2bf(o[rt][reg]);
            }
#pragma unroll
        for (int dkt = 0; dkt < 8; ++dkt) {
            const f32x4 dv4 = *(const f32x4*)(dec + dkt * 16 + quad * 4);
            const bf16x8 ka = *(const bf16x8*)(kdT + (dkt * 16 + r16) * 40 + quad * 8);
            Sacc[dkt] = MFMA16(ka, vb, Sacc[dkt] * dv4);
            u32x2 sp; sp.x = pk2(Sacc[dkt][0], Sacc[dkt][1]); sp.y = pk2(Sacc[dkt][2], Sacc[dkt][3]);
            *(u32x2*)(STw + r16 * 136 + dkt * 16 + quad * 4) = sp;
        }
        __syncthreads();
    }
}

DI void hgrn_finish(const Prm& P, int r) {
    const int tid_ = tid_now(); const int lane = tid_ & 63, w = tid_ >> 6;
    const bf16_t* O0 = (const bf16_t*)(P.ws + WS_M); const bf16_t* O1 = O0 + (size_t)MT * 512;
    const bf16_t* Pb = (const bf16_t*)(P.ws + WS_BIG);
    bf16_t* Y = (bf16_t*)(P.ws + WS_HB);
    const float* ng = P.hgrn_norm_g + r * 512;
    const int c0 = lane * 8;
    for (int row = blockIdx.x * 8 + w; row < MT; row += gridDim.x * 8) {
        const u32x4 a = *(const u32x4*)(O0 + (size_t)row * 512 + c0), bq = *(const u32x4*)(O1 + (size_t)row * 512 + c0);
        const u32x4 gq = *(const u32x4*)(Pb + (size_t)row * 2560 + 2048 + c0);
        float o[8], g[8];
#pragma unroll
        for (int j = 0; j < 4; ++j) {
            o[2 * j] = bflo(a[j]) + bflo(bq[j]); o[2 * j + 1] = bfhi(a[j]) + bfhi(bq[j]);
            g[2 * j] = bflo(gq[j]); g[2 * j + 1] = bfhi(gq[j]);
        }
        float ss = 0.f;
#pragma unroll
        for (int j = 0; j < 8; ++j) ss += o[j] * o[j];
        ss += __shfl_xor(ss, 1); ss += __shfl_xor(ss, 2); ss += __shfl_xor(ss, 4); ss += __shfl_xor(ss, 8);
        const float rn = rsqrtf(ss * (1.0f / 128.0f) + EPSF);
        float y[8];
#pragma unroll
        for (int j = 0; j < 8; ++j) y[j] = o[j] * rn * ng[c0 + j] * (g[j] * sigm(g[j]));
        u32x4 q; q.x = pk2(y[0], y[1]); q.y = pk2(y[2], y[3]); q.z = pk2(y[4], y[5]); q.w = pk2(y[6], y[7]);
        *(u32x4*)(Y + (size_t)row * 1024 + 512 + c0) = q;
    }
}

template <int PASS>
DI void rg_item(const Prm& P, int r, int it, unsigned char* lds) {
    const int tid = tid_now(), lane = tid & 63, w = tid >> 6, r16 = lane & 15, quad = lane >> 4;
    const int cn = it & 63, h = (it >> 6) & 3, b = it >> 8;
    float* xcf = (float*)lds;
    bf16_t* xcb = (bf16_t*)(lds + 16384);
    float* Aa = (float*)(lds + 25088);
    float* Uu = (float*)(lds + 57856);
    const bf16_t* Pb = (const bf16_t*)(P.ws + WS_BIG);
    const bf16_t* Wg = (const bf16_t*)(P.ws + WS_WG) + (size_t)h * 512 * 128;
    float* agg = (float*)(P.ws + WS_AGG);
    const int ch = tid & 127, tg = tid >> 7;
    {
        float cw[4];
#pragma unroll
        for (int k = 0; k < 4; ++k) cw[k] = P.rec_conv_w[(r * 4 + k) * 512 + h * 128 + ch];
        const float cb = P.rec_conv_b[r * 512 + h * 128 + ch];
#pragma unroll
        for (int j = 0; j < 8; ++j) {
            const int i = tg * 8 + j, t = cn * 32 + i;
            float a = cb;
#pragma unroll
            for (int k = 0; k < 4; ++k) {
                const int tt = t + k - 2;
                if (tt >= 0 && tt < SEQ) a += cw[k] * bf2f(Pb[((size_t)b * SEQ + tt) * 2560 + h * 128 + ch]);
            }
            xcf[i * 128 + ch] = a; xcb[i * 136 + ch] = f2bf(a);
        }
    }
    __syncthreads();
    f32x4 acc[2][4];
#pragma unroll
    for (int rt = 0; rt < 2; ++rt)
#pragma unroll
        for (int ct = 0; ct < 4; ++ct) acc[rt][ct] = (f32x4){0.f, 0.f, 0.f, 0.f};
#pragma unroll
    for (int ks = 0; ks < 4; ++ks) {
        bf16x8 xa[2];
#pragma unroll
        for (int rt = 0; rt < 2; ++rt) xa[rt] = *(const bf16x8*)(xcb + (rt * 16 + r16) * 136 + ks * 32 + quad * 8);
#pragma unroll
        for (int ct = 0; ct < 4; ++ct) {
            const bf16x8 wb = *(const bf16x8*)(Wg + (size_t)(w * 64 + ct * 16 + r16) * 128 + ks * 32 + quad * 8);
#pragma unroll
            for (int rt = 0; rt < 2; ++rt) acc[rt][ct] = MFMA16(xa[rt], wb, acc[rt][ct]);
        }
    }
    {
        const int dir = w >> 2;
#pragma unroll
        for (int ctl = 0; ctl < 2; ++ctl) {
            const int j = (w & 3) * 32 + ctl * 16 + r16, c = h * 128 + j;
            const float br = P.rg_b_r[(r * 2 + dir) * 512 + c], bi = P.rg_b_i[(r * 2 + dir) * 512 + c];
            const float lam = P.rg_lambda[(r * 2 + dir) * 512 + c];
            const float sp = log1pf(expf(-lam));
#pragma unroll
            for (int rt = 0; rt < 2; ++rt)
#pragma unroll
                for (int reg = 0; reg < 4; ++reg) {
                    const int i = rt * 16 + quad * 4 + reg;
                    const float rr = sigm(acc[rt][ctl][reg] + br), ii = sigm(acc[rt][ctl + 2][reg] + bi);
                    const float la = -8.0f * rr * sp;
                    const float a = expf(la);
                    const float u = sqrtf(-expm1f(2.0f * la)) * ii * xcf[i * 128 + j];
                    Aa[(dir * 32 + i) * 128 + j] = a; Uu[(dir * 32 + i) * 128 + j] = u;
                }
        }
    }
    __syncthreads();
    if (tid < 256) {
        const int dir = tid >> 7, c = tid & 127;
        const size_t abase = (size_t)((b * 4 + h) * 64);
        if (PASS == 1) {
            float pp = 1.f, hh = 0.f;
            for (int s = 0; s < 32; ++s) {
                const int i = dir ? 31 - s : s;
                const float a = Aa[(dir * 32 + i) * 128 + c], u = Uu[(dir * 32 + i) * 128 + c];
                hh = a * hh + u; pp *= a;
            }
            float2 o; o.x = pp; o.y = hh;
            *(float2*)(agg + (((abase + cn) * 2 + dir) * 128 + c) * 2) = o;
        } else {
            float hc = 0.f;
            if (dir == 0) { for (int k = 0; k < cn; ++k) { const float2 e = *(const float2*)(agg + (((abase + k) * 2 + 0) * 128 + c) * 2); hc = e.x * hc + e.y; } }
            else { for (int k = 63; k > cn; --k) { const float2 e = *(const float2*)(agg + (((abase + k) * 2 + 1) * 128 + c) * 2); hc = e.x * hc + e.y; } }
            for (int s = 0; s < 32; ++s) {
                const int i = dir ? 31 - s : s;
                const float a = Aa[(dir * 32 + i) * 128 + c], u = Uu[(dir * 32 + i) * 128 + c];
                hc = a * hc + u; Uu[(dir * 32 + i) * 128 + c] = hc;
            }
        }
    }
    if (PASS == 2) {
        __syncthreads();
        bf16_t* Y = (bf16_t*)(P.ws + WS_HB);
#pragma unroll
        for (int j = 0; j < 8; ++j) {
            const int i = tg * 8 + j, t = cn * 32 + i; const size_t row = (size_t)b * SEQ + t;
            const float ga = bf2f(Pb[row * 2560 + 512 + h * 128 + ch]);
            const float inner = 0.7978845608028654f * (ga + 0.044715f * ga * ga * ga);
            const float th = 1.0f - 2.0f / (__expf(2.0f * inner) + 1.0f);
            const float gl = 0.5f * ga * (1.0f + th);
            Y[row * 1024 + h * 128 + ch] = f2bf(gl * (Uu[i * 128 + ch] + Uu[(32 + i) * 128 + ch]));
        }
    }
    __syncthreads();
}

DI void att_item(const Prm& P, int al, int it, unsigned char* lds) {
    const int tid = tid_now(), lane = tid & 63, w = tid >> 6, r16 = lane & 15, quad = lane >> 4;
    const int gh = it & 1, n = (it >> 1) & 15, kvh = (it >> 5) & 3, b = it >> 7;
    bf16_t* Ks = (bf16_t*)lds;
    bf16_t* VT = (bf16_t*)(lds + 55296);
    bf16_t* Pw = (bf16_t*)(lds + 105472) + w * (32 * 72);
    const bf16_t* QKV = (const bf16_t*)(P.ws + WS_BIG);
    const float* rc = (const float*)(P.ws + WS_ROPE); const float* rsn = rc + 2048 * 32;
    bf16_t* Oo = (bf16_t*)(P.ws + WS_HB);
    const int k_lo = (n * 128 - 128) < 0 ? 0 : (n * 128 - 128);
    const int k_hi = (n * 128 + 256) > SEQ ? SEQ : (n * 128 + 256);
    const int nk = k_hi - k_lo;
    for (int task = tid; task < nk * 4; task += 512) {
        const int key = task >> 2, dg = task & 3, pos = k_lo + key;
        const bf16_t* src = QKV + ((size_t)b * SEQ + pos) * 1536 + 1024 + kvh * 64 + dg * 8;
        const u32x4 lo = *(const u32x4*)src, hi = *(const u32x4*)(src + 32);
        float x1[8], x2[8], o1[8], o2[8];
#pragma unroll
        for (int j = 0; j < 4; ++j) { x1[2 * j] = bflo(lo[j]); x1[2 * j + 1] = bfhi(lo[j]); x2[2 * j] = bflo(hi[j]); x2[2 * j + 1] = bfhi(hi[j]); }
#pragma unroll
        for (int j = 0; j < 8; ++j) {
            const float cs = rc[pos * 32 + dg * 8 + j], sn = rsn[pos * 32 + dg * 8 + j];
            o1[j] = x1[j] * cs - x2[j] * sn; o2[j] = x2[j] * cs + x1[j] * sn;
        }
        u32x4 w1, w2;
        w1.x = pk2(o1[0], o1[1]); w1.y = pk2(o1[2], o1[3]); w1.z = pk2(o1[4], o1[5]); w1.w = pk2(o1[6], o1[7]);
        w2.x = pk2(o2[0], o2[1]); w2.y = pk2(o2[2], o2[3]); w2.z = pk2(o2[4], o2[5]); w2.w = pk2(o2[6], o2[7]);
        *(u32x4*)(Ks + key * 72 + dg * 8) = w1;
        *(u32x4*)(Ks + key * 72 + 32 + dg * 8) = w2;
    }
    for (int task = tid; task < nk * 8; task += 512) {
        const int key = task >> 3, dg = task & 7, pos = k_lo + key;
        const bf16_t* src = QKV + ((size_t)b * SEQ + pos) * 1536 + 1280 + kvh * 64 + dg * 8;
        const u32x4 vv = *(const u32x4*)src;
#pragma unroll
        for (int j = 0; j < 4; ++j) {
            VT[(dg * 8 + 2 * j) * 392 + key] = (bf16_t)(vv[j] & 0xffffu);
            VT[(dg * 8 + 2 * j + 1) * 392 + key] = (bf16_t)(vv[j] >> 16);
        }
    }
    const int hq = kvh * 4 + gh * 2 + (w >> 2), qrow0 = n * 128 + (w & 3) * 32;
    bf16x8 qa[2][2];
#pragma unroll
    for (int rt = 0; rt < 2; ++rt) {
        const int pos = qrow0 + rt * 16 + r16;
        const bf16_t* src = QKV + ((size_t)b * SEQ + pos) * 1536 + hq * 64 + quad * 8;
        const u32x4 lo = *(const u32x4*)src, hi = *(const u32x4*)(src + 32);
        float x1[8], x2[8], o1[8], o2[8];
#pragma unroll
        for (int j = 0; j < 4; ++j) { x1[2 * j] = bflo(lo[j]); x1[2 * j + 1] = bfhi(lo[j]); x2[2 * j] = bflo(hi[j]); x2[2 * j + 1] = bfhi(hi[j]); }
#pragma unroll
        for (int j = 0; j < 8; ++j) {
            const float cs = rc[pos * 32 + quad * 8 + j], sn = rsn[pos * 32 + quad * 8 + j];
            o1[j] = (x1[j] * cs - x2[j] * sn) * 0.125f; o2[j] = (x2[j] * cs + x1[j] * sn) * 0.125f;
        }
        u32x4 w1, w2;
        w1.x = pk2(o1[0], o1[1]); w1.y = pk2(o1[2], o1[3]); w1.z = pk2(o1[4], o1[5]); w1.w = pk2(o1[6], o1[7]);
        w2.x = pk2(o2[0], o2[1]); w2.y = pk2(o2[2], o2[3]); w2.z = pk2(o2[4], o2[5]); w2.w = pk2(o2[6], o2[7]);
        qa[rt][0] = __builtin_bit_cast(bf16x8, w1); qa[rt][1] = __builtin_bit_cast(bf16x8, w2);
    }
    const float sink = P.att_sinks[al * 16 + hq];
    float mrow[2][4], lrow[2][4];
    f32x4 o[2][4];
#pragma unroll
    for (int rt = 0; rt < 2; ++rt) {
#pragma unroll
        for (int reg = 0; reg < 4; ++reg) { mrow[rt][reg] = sink; lrow[rt][reg] = (r16 == 0) ? 1.0f : 0.0f; }
#pragma unroll
        for (int dt = 0; dt < 4; ++dt) o[rt][dt] = (f32x4){0.f, 0.f, 0.f, 0.f};
    }
    __syncthreads();
    const int nkc = nk >> 6;
    for (int kc = 0; kc < nkc; ++kc) {
        f32x4 s[2][4];
#pragma unroll
        for (int rt = 0; rt < 2; ++rt)
#pragma unroll
            for (int ct = 0; ct < 4; ++ct) s[rt][ct] = (f32x4){0.f, 0.f, 0.f, 0.f};
#pragma unroll
        for (int ks = 0; ks < 2; ++ks)
#pragma unroll
            for (int ct = 0; ct < 4; ++ct) {
                const bf16x8 kb = *(const bf16x8*)(Ks + (kc * 64 + ct * 16 + r16) * 72 + ks * 32 + quad * 8);
#pragma unroll
                for (int rt = 0; rt < 2; ++rt) s[rt][ct] = MFMA16(qa[rt][ks], kb, s[rt][ct]);
            }
#pragma unroll
        for (int rt = 0; rt < 2; ++rt)
#pragma unroll
            for (int reg = 0; reg < 4; ++reg) {
                const int qpos = qrow0 + rt * 16 + quad * 4 + reg;
                float mx = -1e30f;
#pragma unroll
                for (int ct = 0; ct < 4; ++ct) {
                    const int kpos = k_lo + kc * 64 + ct * 16 + r16, d = qpos - kpos;
                    const float sv = (d <= 128 && d >= -128) ? s[rt][ct][reg] : -1e30f;
                    s[rt][ct][reg] = sv; mx = fmaxf(mx, sv);
                }
                mx = fmaxf(mx, __shfl_xor(mx, 1)); mx = fmaxf(mx, __shfl_xor(mx, 2)); mx = fmaxf(mx, __shfl_xor(mx, 4)); mx = fmaxf(mx, __shfl_xor(mx, 8));
                const float mn = fmaxf(mrow[rt][reg], mx), alpha = __expf(mrow[rt][reg] - mn);
                mrow[rt][reg] = mn;
                float ps = 0.f;
#pragma unroll
                for (int ct = 0; ct < 4; ++ct) {
                    const float p = __expf(s[rt][ct][reg] - mn);
                    ps += p;
                    Pw[(rt * 16 + quad * 4 + reg) * 72 + ct * 16 + r16] = f2bf(p);
                }
                lrow[rt][reg] = lrow[rt][reg] * alpha + ps;
#pragma unroll
                for (int dt = 0; dt < 4; ++dt) o[rt][dt][reg] *= alpha;
            }
        __syncthreads();
#pragma unroll
        for (int ks = 0; ks < 2; ++ks) {
            bf16x8 pa[2];
#pragma unroll
            for (int rt = 0; rt < 2; ++rt) pa[rt] = *(const bf16x8*)(Pw + (rt * 16 + r16) * 72 + ks * 32 + quad * 8);
#pragma unroll
            for (int dt = 0; dt < 4; ++dt) {
                const bf16x8 vb = *(const bf16x8*)(VT + (dt * 16 + r16) * 392 + kc * 64 + ks * 32 + quad * 8);
#pragma unroll
                for (int rt = 0; rt < 2; ++rt) o[rt][dt] = MFMA16(pa[rt], vb, o[rt][dt]);
            }
        }
        __syncthreads();
    }
#pragma unroll
    for (int rt = 0; rt < 2; ++rt)
#pragma unroll
        for (int reg = 0; reg < 4; ++reg) {
            float l = lrow[rt][reg];
            l += __shfl_xor(l, 1); l += __shfl_xor(l, 2); l += __shfl_xor(l, 4); l += __shfl_xor(l, 8);
            const float inv = 1.0f / l;
            const int pos = qrow0 + rt * 16 + quad * 4 + reg;
#pragma unroll
            for (int dt = 0; dt < 4; ++dt) Oo[((size_t)b * SEQ + pos) * 1024 + hq * 64 + dt * 16 + r16] = f2bf(o[rt][dt][reg] * inv);
        }
    __syncthreads();
}

__global__ void __launch_bounds__(512, 2) fwd_kernel(Prm P) {
    extern __shared__ __attribute__((aligned(16))) unsigned char lds[];
    cg::grid_group grid = cg::this_grid();
    unsigned char* ws = P.ws;
    const int G = gridDim.x, bid = blockIdx.x;
    prep_phase(P, lds);
    grid.sync();
    for (int ph = 0; ph < 32; ++ph) {
        const int layer = ph >> 3, slot = ph & 7;
        const bool rec = (layer & 1) == 0;
        const int li = layer >> 1;
        const float* g = P.norm_g + (size_t)layer * 4096;
        if (slot == 0 || slot == 3 || slot == 5 || slot == 6) {
            pg8::Gemm gm; Epi E;
            E.rs = (const float*)(ws + WS_RS); E.Pf = (float*)(ws + WS_PF); E.lbv = (const float*)(ws + WS_LB) + li * 1024;
            gm.M = MT;
            if (slot == 0) {
                gm.A = (const bf16_t*)(ws + WS_HB); gm.Bt = (const bf16_t*)(ws + WS_WA); gm.K = 1024;
                gm.N = rec ? 3584 : 1536; E.mode = rec ? 3 : 1; E.O = (bf16_t*)(ws + WS_BIG); E.ldc = rec ? 2560 : 1536;
            } else if (slot == 3) {
                gm.A = (const bf16_t*)(ws + WS_HB); gm.Bt = (const bf16_t*)(ws + WS_WB); gm.K = 1024; gm.N = 1024;
                E.mode = 0; E.O = (bf16_t*)(ws + WS_M); E.ldc = 1024;
            } else if (slot == 5) {
                gm.A = (const bf16_t*)(ws + WS_HB); gm.Bt = (const bf16_t*)(ws + WS_W1); gm.K = 1024; gm.N = 4096;
                E.mode = 2; E.O = (bf16_t*)(ws + WS_BIG); E.ldc = 4096;
            } else {
                gm.A = (const bf16_t*)(ws + WS_BIG); gm.Bt = (const bf16_t*)(ws + WS_W2); gm.K = 4096; gm.N = 1024;
                E.mode = 0; E.O = (bf16_t*)(ws + WS_M); E.ldc = 1024;
            }
            pg8::StaticOrder S; S.init(gm.M, gm.N, G, bid);
            pg8::gemm_phase<Epi, pg8::StaticOrder>((PG8_LAS unsigned char*)lds, gm, S, E);
        } else if (slot == 1) {
            if (rec) {
                if (G >= 128) {
                    if (bid < 64) hgrn_item(P, bid, lds);
                    else for (int it = bid - 64; it < 2048; it += G - 64) rg_item<1>(P, li, it, lds);
                } else {
                    for (int it = bid; it < 64; it += G) hgrn_item(P, it, lds);
                    for (int it = bid; it < 2048; it += G) rg_item<1>(P, li, it, lds);
                }
            } else {
                for (int it = bid; it < 1024; it += G) att_item(P, li, it, lds);
            }
        } else if (slot == 2) {
            if (!rec) continue;
            for (int it = bid; it < 2048; it += G) rg_item<2>(P, li, it, lds);
            hgrn_finish(P, li);
        } else if (slot == 4) {
            resnorm_phase((const bf16_t*)(ws + WS_M), layer == 0 ? P.x : P.out, P.out, (bf16_t*)(ws + WS_HB), (float*)(ws + WS_RS), g + 1024);
        } else {
            resnorm_phase((const bf16_t*)(ws + WS_M), P.out, P.out, (bf16_t*)(ws + WS_HB), (float*)(ws + WS_RS), g + 3072);
            if (layer < 3) conv_layer(P, layer + 1, lds);
        }
        grid.sync();
    }
}

extern "C" void kernel_launch(void* const* d_in, const int* in_sizes, int n_in, void* d_out, int out_size, void* d_ws, size_t ws_size, hipStream_t stream) {
    static int grid_blocks = 0;
    if (!grid_blocks) {
        int dev = 0, cus = 0, per_cu = 0;
        hipGetDevice(&dev);
        hipDeviceGetAttribute(&cus, hipDeviceAttributeMultiprocessorCount, dev);
        hipFuncSetAttribute((const void*)fwd_kernel, hipFuncAttributeMaxDynamicSharedMemorySize, LDS_BYTES);
        hipOccupancyMaxActiveBlocksPerMultiprocessor(&per_cu, (const void*)fwd_kernel, 512, LDS_BYTES);
        if (per_cu < 1) per_cu = 1;
        grid_blocks = cus * 1;
        if (ws_size < WS_END) fprintf(stderr, "kernel_launch: workspace too small: %zu < %zu\n", ws_size, (size_t)WS_END);
        (void)hipGetLastError();
    }
    Prm p{};
    p.x = (const float*)d_in[0]; p.norm_g = (const float*)d_in[1]; p.rec_w_in = (const float*)d_in[2]; p.rec_conv_w = (const float*)d_in[3];
    p.rec_conv_b = (const float*)d_in[4]; p.rg_w_r = (const float*)d_in[5]; p.rg_b_r = (const float*)d_in[6]; p.rg_w_i = (const float*)d_in[7];
    p.rg_b_i = (const float*)d_in[8]; p.rg_lambda = (const float*)d_in[9]; p.lb_logits = (const float*)d_in[10]; p.hgrn_norm_g = (const float*)d_in[11];
    p.rec_w_out = (const float*)d_in[12]; p.att_w_qkv = (const float*)d_in[13]; p.att_sinks = (const float*)d_in[14]; p.att_w_o = (const float*)d_in[15];
    p.mlp_w1 = (const float*)d_in[16]; p.mlp_w2 = (const float*)d_in[17];
    p.out = (float*)d_out; p.ws = (unsigned char*)d_ws;
    void* args[] = {&p};
    hipError_t e = hipLaunchCooperativeKernel((const void*)fwd_kernel, dim3(grid_blocks), dim3(512), args, LDS_BYTES, stream);
    if (e != hipSuccess) fprintf(stderr, "cooperative launch failed: %s (grid %d)\n", hipGetErrorString(e), grid_blocks);
}
```

```cpp
#include <hip/hip_runtime.h>
#include <hip/hip_cooperative_groups.h>
#include <cstdio>
namespace cg = cooperative_groups;
namespace pg8 {
#define PG8_LAS __attribute__((address_space(3)))
typedef unsigned short bf16_t;
typedef short bf16x8 __attribute__((ext_vector_type(8)));
typedef float f32x4 __attribute__((ext_vector_type(4)));
typedef unsigned u32x4 __attribute__((ext_vector_type(4)));
constexpr int BM = 256, BK = 64, HALF = 128, HTB = HALF * BK * 2  , STAGE_BYTES = 8 * HTB, NXCD = 8, WGM = 8;

__host__ __device__ __forceinline__ int lds_byte(int r, int c) { const int st = (r >> 4) * 2 + (c >> 5), rr = r & 15, cc = c & 31, ob = rr * 64 + cc * 2; return st * 1024 + (ob ^ (((ob >> 9) & 1) << 5)); }
__host__ __device__ __forceinline__ void stage_rc(int b, int& R, int& C) { const int st = b / 1024, sb = b % 1024, swz = sb ^ (((sb >> 9) & 1) << 5); R = (st >> 1) * 16 + swz / 64; C = (st & 1) * 32 + (swz % 64) / 2; }
__host__ __device__ __forceinline__ int perm32(int rho) { const int n = rho >> 4, i = rho & 15; return 8 * (i >> 2) + 4 * n + (i & 3); }

struct Unit { int pm, pn; };
struct Gemm { const bf16_t* A; const bf16_t* Bt; int M, N, K; };

struct StaticOrder {
    int nM, nN, nwg, G, c;
    __host__ __device__ void init(int M, int N, int G_, int c_) { nM = M / BM; nN = N / BM; nwg = nM * nN; G = G_; c = c_; }
    __host__ __device__ bool next(int i, Unit& u) const {
        const long L = (long)i * G + c; if (L >= nwg) return false;
        int wgid = (int)L; { const int q = nwg / NXCD, r = nwg % NXCD, xcd = wgid % NXCD, off = wgid / NXCD; wgid = (xcd < r ? xcd * (q + 1) : r * (q + 1) + (xcd - r) * q) + off; }
        const int nig = WGM * nN, gid = wgid / nig, fm = gid * WGM, gsz = (nM - fm) < WGM ? (nM - fm) : WGM;
        u.pm = fm + ((wgid % nig) % gsz); u.pn = (wgid % nig) / gsz; return true;
    }
    __device__ __forceinline__ void a_ready(const Unit&) const {}
    __device__ __forceinline__ void done(const Unit&) const {}
};

template <class Epi, class Sched, bool STAMP = false>
__device__ __forceinline__ void gemm_phase(PG8_LAS unsigned char* lds, const Gemm g, const Sched& S, const Epi& E, unsigned long long* stamps = nullptr) {
    int tid = threadIdx.x; asm volatile("" : "+v"(tid)); const int wid = __builtin_amdgcn_readfirstlane(tid >> 6), lane = tid & 63, wr = wid >> 2, wc = wid & 3, fr = lane & 15, fq = lane >> 4;
    const int K = g.K, nt = K / BK;
    int ts_lo = 0, ts_hi = 0, nts = 0; const unsigned long long rt_entry = STAMP ? (unsigned long long)wall_clock64() : 0ull;
#define PG8_STAMP() do { if (STAMP && wid == 0 && nts < 64) { const unsigned long long _c = (unsigned long long)clock64(); \
        ts_lo = (lane == nts) ? (int)(unsigned)_c : ts_lo; ts_hi = (lane == nts) ? (int)(unsigned)(_c >> 32) : ts_hi; ++nts; } } while (0)
    PG8_STAMP();
    unsigned voffA[2], voffB[2];
#pragma unroll
    for (int i = 0; i < 2; ++i) { int R, C; stage_rc(tid * 16 + i * 8192, R, C); const int Rb = Epi::PERM ? ((R & ~31) + perm32(R & 31)) : R;
        voffA[i] = (unsigned)(R * K + C) * 2u; voffB[i] = (unsigned)(Rb * K + C) * 2u; }
    const size_t kstep = (size_t)(BK * 2);
    const size_t hstep = (size_t)HALF * K * 2;
    const size_t tstep = 2 * hstep;
    const unsigned ldsw = (unsigned)wid * 1024u;
    const int aoff = lds_byte(wr * 64 + fr, fq * 8), boff = lds_byte(wc * 32 + fr, fq * 8);
#define PG8_SA(b, h) (((b) * 2 + (h)) * HTB)
#define PG8_SB(b, h) ((4 + (b) * 2 + (h)) * HTB)
#define PG8_STAGE(bufoff, gbase, voff) do { _Pragma("unroll") for (int _i = 0; _i < 2; ++_i) \
        __builtin_amdgcn_global_load_lds((const unsigned*)((const char*)(gbase) + (voff)[_i]), (PG8_LAS unsigned*)(lds + (bufoff) + ldsw + _i * 8192), 16, 0, 0); } while (0)
#define PG8_LDA(dst, b, h) do { _Pragma("unroll") for (int m = 0; m < 4; ++m) _Pragma("unroll") for (int k = 0; k < 2; ++k) dst[m][k] = *(const PG8_LAS bf16x8*)(lds + PG8_SA(b, h) + aoff + m * 2048 + k * 1024); } while (0)
#define PG8_LDB(dst, b, h) do { _Pragma("unroll") for (int n = 0; n < 2; ++n) _Pragma("unroll") for (int k = 0; k < 2; ++k) dst[n][k] = *(const PG8_LAS bf16x8*)(lds + PG8_SB(b, h) + boff + n * 2048 + k * 1024); } while (0)
#define PG8_MMA(ai, bj, At, Bt) do { __builtin_amdgcn_s_setprio(1); _Pragma("unroll") for (int m = 0; m < 4; ++m) _Pragma("unroll") for (int n = 0; n < 2; ++n) _Pragma("unroll") for (int k = 0; k < 2; ++k) \
        acc[ai][bj][m][n] = __builtin_amdgcn_mfma_f32_16x16x32_bf16(Bt[n][k], At[m][k], acc[ai][bj][m][n], 0, 0, 0); __builtin_amdgcn_s_setprio(0); } while (0)
#define PG8_WAIT_V(n) asm volatile("s_waitcnt vmcnt(" #n ")" ::: "memory")
#define PG8_WAIT_L(n) asm volatile("s_waitcnt lgkmcnt(" #n ")" ::: "memory")
#define PG8_BAR __builtin_amdgcn_s_barrier()
#define PG8_SCHED __builtin_amdgcn_sched_barrier(0)
    Unit cur, nxt; int ui = 0;
    if (!S.next(0, cur)) return;
    f32x4 acc[2][2][4][2];
#pragma unroll
    for (int a = 0; a < 2; ++a)
#pragma unroll
        for (int b = 0; b < 2; ++b)
#pragma unroll
            for (int m = 0; m < 4; ++m)
#pragma unroll
                for (int n = 0; n < 2; ++n) acc[a][b][m][n] = (f32x4){0.f, 0.f, 0.f, 0.f};
    bf16x8 At[4][2], B0[2][2], B1[2][2];
    const char* cA = (const char*)g.A + (size_t)cur.pm * tstep; const char* cB = (const char*)g.Bt + (size_t)cur.pn * tstep;
    S.a_ready(cur);
    PG8_STAGE(PG8_SB(0, 0), cB, voffB); PG8_STAGE(PG8_SA(0, 0), cA, voffA); PG8_STAGE(PG8_SB(0, 1), cB + hstep, voffB); PG8_STAGE(PG8_SA(0, 1), cA + hstep, voffA);
    if (wr == 1) PG8_BAR;
    PG8_WAIT_V(4); PG8_BAR;
    PG8_STAGE(PG8_SB(1, 0), cB + kstep, voffB); PG8_STAGE(PG8_SA(1, 0), cA + kstep, voffA); PG8_STAGE(PG8_SB(1, 1), cB + hstep + kstep, voffB);
    PG8_WAIT_V(6); PG8_BAR;
    PG8_STAMP();
    for (;;) {
        const bool has_next = S.next(ui + 1, nxt);
        const char* nA = has_next ? (const char*)g.A + (size_t)nxt.pm * tstep : cA; const char* nB = has_next ? (const char*)g.Bt + (size_t)nxt.pn * tstep : cB;
        for (int t = 0; t < nt; t += 2) {
            const bool last = (t == nt - 2);
            const char* a1 = cA + (size_t)(t + 1) * kstep;
            const char* a2 = last ? nA : cA + (size_t)(t + 2) * kstep; const char* b2 = last ? nB : cB + (size_t)(t + 2) * kstep;
            const char* a3 = a2 + kstep; const char* b3 = b2 + kstep;
            if (last && has_next) S.a_ready(nxt);
            PG8_LDB(B0, 0, 0); PG8_SCHED; PG8_LDA(At, 0, 0); PG8_STAGE(PG8_SA(1, 1), a1 + hstep, voffA);
            PG8_WAIT_L(8); PG8_BAR; PG8_WAIT_L(0); PG8_MMA(0, 0, At, B0); PG8_BAR; PG8_SCHED;
            PG8_LDB(B1, 0, 1); PG8_STAGE(PG8_SB(0, 0), b2, voffB);
            PG8_BAR; PG8_WAIT_L(0); PG8_MMA(0, 1, At, B1); PG8_BAR;
            PG8_LDA(At, 0, 1); PG8_STAGE(PG8_SA(0, 0), a2, voffA);
            PG8_BAR; PG8_WAIT_L(0); PG8_MMA(1, 0, At, B0); PG8_BAR; PG8_SCHED;
            PG8_STAGE(PG8_SB(0, 1), b2 + hstep, voffB);
            PG8_WAIT_V(6); PG8_BAR; PG8_MMA(1, 1, At, B1); PG8_BAR;
            PG8_LDB(B0, 1, 0); PG8_SCHED; PG8_LDA(At, 1, 0); PG8_STAGE(PG8_SA(0, 1), a2 + hstep, voffA);
            PG8_WAIT_L(8); PG8_BAR; PG8_WAIT_L(0); PG8_MMA(0, 0, At, B0); PG8_BAR; PG8_SCHED;
            PG8_LDB(B1, 1, 1); PG8_STAGE(PG8_SB(1, 0), b3, voffB);
            PG8_BAR; PG8_WAIT_L(0); PG8_MMA(0, 1, At, B1); PG8_BAR;
            PG8_LDA(At, 1, 1); PG8_STAGE(PG8_SA(1, 0), a3, voffA);
            PG8_BAR; PG8_WAIT_L(0); PG8_MMA(1, 0, At, B0); PG8_BAR; PG8_SCHED;
            PG8_STAGE(PG8_SB(1, 1), b3 + hstep, voffB);
            PG8_WAIT_V(6); PG8_BAR; PG8_MMA(1, 1, At, B1); PG8_BAR;
        }
        PG8_STAMP();
        if constexpr (!Epi::AFTER_DRAIN) { E(acc, cur, wr, wc, fr, fq); S.done(cur); }
        PG8_STAMP();
        if (!has_next) break;
#pragma unroll
        for (int a = 0; a < 2; ++a)
#pragma unroll
            for (int b = 0; b < 2; ++b)
#pragma unroll
                for (int m = 0; m < 4; ++m)
#pragma unroll
                    for (int n = 0; n < 2; ++n) acc[a][b][m][n] = (f32x4){0.f, 0.f, 0.f, 0.f};
        cur = nxt; cA = nA; cB = nB; ++ui;
    }
    PG8_WAIT_V(0);
    if (wr == 0) PG8_BAR;
    PG8_BAR;
    if constexpr (Epi::AFTER_DRAIN) { E.fused(acc, cur, wr, wc, fr, fq, lds, wid, lane); S.done(cur); }
    PG8_STAMP();
    if (STAMP && wid == 0) { stamps[lane] = lane < nts ? (((unsigned long long)(unsigned)ts_hi << 32) | (unsigned)ts_lo) : 0ull;
        if (lane == 62) stamps[62] = rt_entry; if (lane == 63) stamps[63] = (unsigned long long)wall_clock64(); }
#undef PG8_STAMP
#undef PG8_SA
#undef PG8_SB
#undef PG8_STAGE
#undef PG8_LDA
#undef PG8_LDB
#undef PG8_MMA
#undef PG8_WAIT_V
#undef PG8_WAIT_L
#undef PG8_BAR
#undef PG8_SCHED
}
}


using pg8::bf16_t; using pg8::bf16x8; using pg8::f32x4; using pg8::u32x4;
typedef unsigned u32x2 __attribute__((ext_vector_type(2)));
#define DI __device__ __forceinline__
#define MFMA16(a, b, c) __builtin_amdgcn_mfma_f32_16x16x32_bf16((a), (b), (c), 0, 0, 0)

constexpr int MT = 16384, DM = 1024, SEQ = 2048;
constexpr int LDS_BYTES = 147456;
constexpr float EPSF = 1e-6f;

constexpr size_t WS_WA = 0;
constexpr size_t WS_WB = WS_WA + 7340032;
constexpr size_t WS_WG = WS_WB + 2097152;
constexpr size_t WS_W1 = WS_WG + 524288;
constexpr size_t WS_W2 = WS_W1 + 8388608;
constexpr size_t WS_HB = WS_W2 + 8388608;
constexpr size_t WS_M  = WS_HB + 33554432;
constexpr size_t WS_RS = WS_M + 33554432;
constexpr size_t WS_ROPE = WS_RS + 65536;
constexpr size_t WS_LB = WS_ROPE + 524288;
constexpr size_t WS_BAR = WS_LB + 32768;
constexpr size_t WS_AGG = WS_LB + 65536;
constexpr size_t WS_BIG = WS_AGG + 4194304;
constexpr size_t WS_PF = WS_BIG + 83886080;
constexpr size_t WS_CARRY = WS_PF + 67108864;
constexpr size_t WS_END = WS_CARRY + 2097152;

struct Prm {
    const float* x; const float* norm_g; const float* rec_w_in; const float* rec_conv_w; const float* rec_conv_b;
    const float* rg_w_r; const float* rg_b_r; const float* rg_w_i; const float* rg_b_i; const float* rg_lambda;
    const float* lb_logits; const float* hgrn_norm_g; const float* rec_w_out; const float* att_w_qkv; const float* att_sinks;
    const float* att_w_o; const float* mlp_w1; const float* mlp_w2;
    float* out; unsigned char* ws;
};

DI int tid_now() { int t = threadIdx.x; asm volatile("" : "+v"(t)); return t; }
DI int bid_now() { int t = blockIdx.x; asm volatile("" : "+s"(t)); return t; }
typedef __bf16 bf16v2_t __attribute__((ext_vector_type(2)));
typedef float f32v2_t __attribute__((ext_vector_type(2)));
DI unsigned pk2(float lo, float hi) { f32v2_t v = {lo, hi}; bf16v2_t r = __builtin_convertvector(v, bf16v2_t); return __builtin_bit_cast(unsigned, r); }
DI bf16_t f2bf(float f) { return (bf16_t)(pk2(f, f) & 0xffffu); }
DI float bf2f(bf16_t b) { return __uint_as_float(((unsigned)b) << 16); }
DI float bflo(unsigned u) { return __uint_as_float(u << 16); }
DI float bfhi(unsigned u) { return __uint_as_float(u & 0xffff0000u); }
DI float sigm(float x) { return __builtin_amdgcn_rcpf(1.0f + __expf(-x)); }
DI float wave_sum(float v) { for (int o = 32; o > 0; o >>= 1) v += __shfl_xor(v, o); return v; }

struct Epi {
    static constexpr bool PERM = true, AFTER_DRAIN = false;
    int mode; bf16_t* O; int ldc; float* Pf; const PG8_LAS float* lbl;
    DI void operator()(const f32x4 (&acc)[2][2][4][2], const pg8::Unit& u, int wr, int wc, int fr, int fq) const {
        const int row0 = u.pm * 256 + wr * 64 + fr, col0 = u.pn * 256 + wc * 32 + 8 * fq;
        const int ctile = u.pn * 256;
        const bool tof32 = (mode == 3) && (ctile >= 1536) && (ctile < 2560);
        const int cshift = (mode == 3) ? (ctile < 1536 ? 0 : (tof32 ? -1536 : -1024)) : 0;
#pragma unroll
        for (int ai = 0; ai < 2; ++ai)
#pragma unroll
            for (int m = 0; m < 4; ++m) {
                const int row = row0 + ai * 128 + m * 16;
#pragma unroll
                for (int bj = 0; bj < 2; ++bj) {
                    f32x4 v0 = acc[ai][bj][m][0], v1 = acc[ai][bj][m][1];
                    const int col = col0 + bj * 128 + cshift;
                    if (tof32) {
                        const f32x4 lb0 = *(const PG8_LAS f32x4*)(lbl + col), lb1 = *(const PG8_LAS f32x4*)(lbl + col + 4);
                        f32x4 o0, o1;
#pragma unroll
                        for (int j = 0; j < 4; ++j) { o0[j] = __logf(lb0[j] + (1.0f - lb0[j]) * sigm(v0[j])); o1[j] = __logf(lb1[j] + (1.0f - lb1[j]) * sigm(v1[j])); }
                        u32x4 w; w.x = pk2(o0[0], o0[1]); w.y = pk2(o0[2], o0[3]); w.z = pk2(o1[0], o1[1]); w.w = pk2(o1[2], o1[3]);
                        *(u32x4*)((unsigned char*)Pf + (size_t)row * 4096 + (col >> 7) * 512 + (col & 127) * 2) = w;
                    } else {
                        if (mode == 2) {
#pragma unroll
                            for (int j = 0; j < 4; ++j) { const float t0 = fmaxf(v0[j], 0.f), t1 = fmaxf(v1[j], 0.f); v0[j] = t0 * t0; v1[j] = t1 * t1; }
                        }
                        u32x4 w; w.x = pk2(v0[0], v0[1]); w.y = pk2(v0[2], v0[3]); w.z = pk2(v1[0], v1[1]); w.w = pk2(v1[2], v1[3]);
                        *(u32x4*)(O + (size_t)row * ldc + col) = w;
                    }
                }
            }
    }
};

DI void conv_wt(const float* __restrict__ src, bf16_t* __restrict__ dst, int K, int N, const float* __restrict__ g, float* tile, int vb, int nvb) {
    const int tid = tid_now();
    const int tn = N / 64, tk = K / 64, nt = tn * tk;
    const int n4 = (tid & 15) * 4, kr = tid >> 4;
    f32x4 nv[2]; float ng[2];
    auto ld = [&](int t) {
        const int k0 = (t / tn) * 64, n0 = (t % tn) * 64;
#pragma unroll
        for (int p = 0; p < 2; ++p) {
            const int k = kr + 32 * p;
            nv[p] = *(const f32x4*)(src + (size_t)(k0 + k) * N + n0 + n4);
            ng[p] = g ? g[k0 + k] : 1.0f;
        }
    };
    if (vb < nt) ld(vb);
    for (int t = vb; t < nt; t += nvb) {
        const int k0 = (t / tn) * 64, n0 = (t % tn) * 64;
#pragma unroll
        for (int p = 0; p < 2; ++p) {
            const int k = kr + 32 * p;
            const f32x4 v = nv[p] * ng[p];
            tile[k * 65 + n4] = v[0]; tile[k * 65 + n4 + 1] = v[1]; tile[k * 65 + n4 + 2] = v[2]; tile[k * 65 + n4 + 3] = v[3];
        }
        if (t + nvb < nt) ld(t + nvb);
        __syncthreads();
        { const int n = tid & 63, kg = tid >> 6;
          u32x4 o;
          o.x = pk2(tile[(kg * 8 + 0) * 65 + n], tile[(kg * 8 + 1) * 65 + n]); o.y = pk2(tile[(kg * 8 + 2) * 65 + n], tile[(kg * 8 + 3) * 65 + n]);
          o.z = pk2(tile[(kg * 8 + 4) * 65 + n], tile[(kg * 8 + 5) * 65 + n]); o.w = pk2(tile[(kg * 8 + 6) * 65 + n], tile[(kg * 8 + 7) * 65 + n]);
          *(u32x4*)(dst + (size_t)(n0 + n) * K + k0 + kg * 8) = o; }
        __syncthreads();
    }
}
DI void conv_gates(const float* __restrict__ w_r, const float* __restrict__ w_i, bf16_t* __restrict__ dst) {
    for (int idx = blockIdx.x * 512 + tid_now(); idx < 4 * 512 * 128; idx += gridDim.x * 512) {
        const int k = idx & 127, np = (idx >> 7) & 511, h = idx >> 16;
        const int w = np >> 6, ct = (np >> 4) & 3, jj = np & 15;
        const int dir = w >> 2, gate = ct >> 1, j = (w & 3) * 32 + (ct & 1) * 16 + jj;
        const float* s = gate ? w_i : w_r;
        dst[idx] = f2bf(s[((dir * 4 + h) * 128 + k) * 128 + j]);
    }
}
DI void conv_layer(const Prm& P, int layer, unsigned char* lds) {
    float* tile = (float*)lds;
    unsigned char* ws = P.ws;
    const float* g = P.norm_g + (size_t)layer * 4096;
    const int vb = blockIdx.x, nvb = gridDim.x;
    if ((layer & 1) == 0) {
        const int r = layer >> 1;
        conv_wt(P.rec_w_in + (size_t)r * 1024 * 3584, (bf16_t*)(ws + WS_WA), 1024, 3584, g, tile, vb, nvb);
        conv_wt(P.rec_w_out + (size_t)r * 1024 * 1024, (bf16_t*)(ws + WS_WB), 1024, 1024, nullptr, tile, vb, nvb);
        conv_gates(P.rg_w_r + (size_t)r * 131072, P.rg_w_i + (size_t)r * 131072, (bf16_t*)(ws + WS_WG));
    } else {
        const int a = layer >> 1;
        conv_wt(P.att_w_qkv + (size_t)a * 1024 * 1536, (bf16_t*)(ws + WS_WA), 1024, 1536, g, tile, vb, nvb);
        conv_wt(P.att_w_o + (size_t)a * 1024 * 1024, (bf16_t*)(ws + WS_WB), 1024, 1024, nullptr, tile, vb, nvb);
    }
}
DI void conv_mlp(const Prm& P, int layer, unsigned char* lds, int vb, int nvb) {
    float* tile = (float*)lds;
    unsigned char* ws = P.ws;
    const float* g = P.norm_g + (size_t)layer * 4096;
    conv_wt(P.mlp_w1 + (size_t)layer * 1024 * 4096, (bf16_t*)(ws + WS_W1), 1024, 4096, g + 2048, tile, vb, nvb);
    conv_wt(P.mlp_w2 + (size_t)layer * 4096 * 1024, (bf16_t*)(ws + WS_W2), 4096, 1024, nullptr, tile, vb, nvb);
}

DI void resnorm_phase(const bf16_t* __restrict__ m, bf16_t* hb, float* rms, const float* __restrict__ gp, float* __restrict__ fout) {
    const int tid_ = tid_now(); const int lane = tid_ & 63, w = tid_ >> 6;
    for (int row = blockIdx.x * 8 + w; row < MT; row += gridDim.x * 8) {
        f32x4 h[4], mv[4]; float ss = 0.f;
        const float r0 = rms[row];
#pragma unroll
        for (int i = 0; i < 4; ++i) {
            const u32x2 q = *(const u32x2*)(m + (size_t)row * 1024 + i * 256 + lane * 4);
            const u32x2 hq = *(const u32x2*)(hb + (size_t)row * 1024 + i * 256 + lane * 4);
            mv[i][0] = bflo(q.x); mv[i][1] = bfhi(q.x); mv[i][2] = bflo(q.y); mv[i][3] = bfhi(q.y);
            h[i][0] = bflo(hq.x) * r0; h[i][1] = bfhi(hq.x) * r0; h[i][2] = bflo(hq.y) * r0; h[i][3] = bfhi(hq.y) * r0;
            ss += mv[i][0] * mv[i][0] + mv[i][1] * mv[i][1] + mv[i][2] * mv[i][2] + mv[i][3] * mv[i][3];
        }
        ss = wave_sum(ss);
        const float rm = rsqrtf(ss * (1.0f / 1024.0f) + EPSF);
        float s2 = 0.f;
#pragma unroll
        for (int i = 0; i < 4; ++i) {
            const f32x4 gv = *(const f32x4*)(gp + i * 256 + lane * 4);
            h[i] = h[i] + mv[i] * rm * gv;
            if (fout) *(f32x4*)(fout + (size_t)row * 1024 + i * 256 + lane * 4) = h[i];
            s2 += h[i][0] * h[i][0] + h[i][1] * h[i][1] + h[i][2] * h[i][2] + h[i][3] * h[i][3];
        }
        if (fout) continue;
        s2 = wave_sum(s2);
        const float s2m = s2 * (1.0f / 1024.0f) + EPSF, rn = rsqrtf(s2m);
#pragma unroll
        for (int i = 0; i < 4; ++i) {
            u32x2 q; q.x = pk2(h[i][0] * rn, h[i][1] * rn); q.y = pk2(h[i][2] * rn, h[i][3] * rn);
            *(u32x2*)(hb + (size_t)row * 1024 + i * 256 + lane * 4) = q;
        }
        if (lane == 0) rms[row] = s2m * rn;
    }
}
DI void input_phase(const float* __restrict__ x, bf16_t* __restrict__ hb, float* __restrict__ rms) {
    const int tid_ = tid_now(); const int lane = tid_ & 63, w = tid_ >> 6;
    for (int row = blockIdx.x * 8 + w; row < MT; row += gridDim.x * 8) {
        f32x4 h[4]; float s2 = 0.f;
#pragma unroll
        for (int i = 0; i < 4; ++i) {
            h[i] = *(const f32x4*)(x + (size_t)row * 1024 + i * 256 + lane * 4);
            s2 += h[i][0] * h[i][0] + h[i][1] * h[i][1] + h[i][2] * h[i][2] + h[i][3] * h[i][3];
        }
        s2 = wave_sum(s2);
        const float s2m = s2 * (1.0f / 1024.0f) + EPSF, rn = rsqrtf(s2m);
#pragma unroll
        for (int i = 0; i < 4; ++i) {
            u32x2 q; q.x = pk2(h[i][0] * rn, h[i][1] * rn); q.y = pk2(h[i][2] * rn, h[i][3] * rn);
            *(u32x2*)(hb + (size_t)row * 1024 + i * 256 + lane * 4) = q;
        }
        if (lane == 0) rms[row] = s2m * rn;
    }
}

DI void prep_phase(const Prm& P, unsigned char* lds) {
    unsigned char* ws = P.ws;
    float* lbv = (float*)(ws + WS_LB);
    float* rc = (float*)(ws + WS_ROPE); float* rsn = rc + 2048 * 32;
    const int gt = blockIdx.x * 512 + tid_now(), gn = gridDim.x * 512;
    for (int i = gt; i < 1024; i += gn) {
        const int d = i >> 9, c = i & 511;
        const float l0 = P.lb_logits[(d * 2 + 0) * 512 + c], l1 = P.lb_logits[(d * 2 + 1) * 512 + c];
        const float mx = fmaxf(l0, l1), e0 = expf(l0 - mx), e1 = expf(l1 - mx);
        lbv[(0 * 2 + d) * 512 + c] = 0.f;
        lbv[(1 * 2 + d) * 512 + c] = e1 / (e0 + e1);
    }
    { float* rgc = (float*)(ws + WS_LB + 8192);
      for (int i = gt; i < 2048; i += gn) {
          rgc[i * 3 + 0] = P.rg_b_r[i]; rgc[i * 3 + 1] = P.rg_b_i[i];
          rgc[i * 3 + 2] = -8.0f * log1pf(expf(-P.rg_lambda[i]));
      } }
    for (int i = gt; i < 2048 * 32; i += gn) {
        const int pos = i >> 5, f = i & 31;
        const float inv = powf(10000.0f, -(float)(2 * f) / 64.0f);
        const float ang = (float)pos * inv;
        rc[i] = cosf(ang); rsn[i] = sinf(ang);
    }
    conv_layer(P, 0, lds);
    input_phase(P.x, (bf16_t*)(ws + WS_HB), (float*)(ws + WS_RS));
}

DI void hgrn_pre(const Prm& P, int it, unsigned char* lds) {
    const int tid = tid_now(), lane = tid & 63, w = tid >> 6, r16 = lane & 15, quad = lane >> 4;
    const int na = it & 63, h = (it >> 6) & 3, b = it >> 8;
    bf16_t* qeL = (bf16_t*)lds;
    bf16_t* keL = qeL + 2 * 32 * 136;
    bf16_t* vT = keL + 2 * 32 * 136;
    float* gtot = (float*)(vT + 128 * 40);
    bf16_t* attL = (bf16_t*)(gtot + 1024);
    unsigned char* PfB = P.ws + WS_PF; unsigned char* PbB = P.ws + WS_BIG;
    bf16_t* Ob = (bf16_t*)(P.ws + WS_M);
    const int ch = tid & 127, tg = tid >> 7;
    const size_t row0 = (size_t)b * SEQ + na * 32;
    float lf0[8], lf1[8], q[8], v[8], c0[8], c1[8];
#pragma unroll
    for (int j = 0; j < 8; ++j) {
        const size_t row = row0 + tg * 8 + j;
        lf0[j] = bf2f(*(const bf16_t*)(PfB + row * 4096 + h * 512 + ch * 2));
        lf1[j] = bf2f(*(const bf16_t*)(PfB + row * 4096 + 2048 + h * 512 + ch * 2));
        q[j] = bf2f(*(const bf16_t*)(PbB + row * 5120 + (1024 + h * 128 + ch) * 2));
        v[j] = bf2f(*(const bf16_t*)(PbB + row * 5120 + (1536 + h * 128 + ch) * 2));
    }
    { float run = 0.f;
#pragma unroll
      for (int j = 0; j < 8; ++j) { run += lf0[j]; c0[j] = run; }
      run = 0.f;
#pragma unroll
      for (int j = 7; j >= 0; --j) { run += lf1[j]; c1[j] = run; } }
    gtot[tg * 128 + ch] = c0[7]; gtot[512 + tg * 128 + ch] = c1[0];
    asm volatile("s_waitcnt vmcnt(0)" ::: "memory");
    __syncthreads();
    float pre0 = 0.f, bt0 = 0.f, pre1 = 0.f, bt1 = 0.f;
#pragma unroll
    for (int g = 0; g < 4; ++g) {
        const float x0 = gtot[g * 128 + ch], x1 = gtot[512 + g * 128 + ch];
        bt0 += x0; bt1 += x1; if (g < tg) pre0 += x0; if (g > tg) pre1 += x1;
    }
    {
        float kd0[8], kd1[8];
#pragma unroll
        for (int j = 0; j < 8; ++j) {
            const int i = tg * 8 + j;
            const float bc0 = pre0 + c0[j], bc1 = pre1 + c1[j];
            const float k0 = 1.0f - __expf(lf0[j]), k1 = 1.0f - __expf(lf1[j]);
            const bf16_t qe0 = f2bf(q[j] * __expf(bc0)), qe1 = f2bf(q[j] * __expf(bc1));
            qeL[i * 136 + ch] = qe0; qeL[(32 + i) * 136 + ch] = qe1;
            keL[i * 136 + ch] = f2bf(k0 * __expf(-bc0)); keL[(32 + i) * 136 + ch] = f2bf(k1 * __expf(-bc1));
            kd0[j] = k0 * __expf(bt0 - bc0); kd1[j] = k1 * __expf(bt1 - bc1);
            *(bf16_t*)(PfB + (row0 + i) * 4096 + h * 512 + ch * 2) = qe0;
            *(bf16_t*)(PfB + (row0 + i) * 4096 + 2048 + h * 512 + ch * 2) = qe1;
        }
        u32x4 p0, p1, vp;
        p0.x = pk2(kd0[0], kd0[1]); p0.y = pk2(kd0[2], kd0[3]); p0.z = pk2(kd0[4], kd0[5]); p0.w = pk2(kd0[6], kd0[7]);
        p1.x = pk2(kd1[0], kd1[1]); p1.y = pk2(kd1[2], kd1[3]); p1.z = pk2(kd1[4], kd1[5]); p1.w = pk2(kd1[6], kd1[7]);
        vp.x = pk2(v[0], v[1]); vp.y = pk2(v[2], v[3]); vp.z = pk2(v[4], v[5]); vp.w = pk2(v[6], v[7]);
        const size_t srow = row0 + (ch >> 2);
        *(u32x4*)(PfB + srow * 4096 + h * 512 + 256 + (ch & 3) * 64 + tg * 16) = p0;
        *(u32x4*)(PfB + srow * 4096 + 2048 + h * 512 + 256 + (ch & 3) * 64 + tg * 16) = p1;
        *(u32x4*)(PbB + srow * 5120 + (1536 + h * 128) * 2 + (ch & 3) * 64 + tg * 16) = vp;
        *(u32x4*)(vT + ch * 40 + tg * 8) = vp;
        if (tg < 2) {
            const float dv = __expf(tg ? bt1 : bt0);
            *(float*)(PbB + (row0 + tg * 2 + (ch >> 6)) * 5120 + (1024 + h * 128) * 2 + (ch & 63) * 4) = dv;
        }
    }
    __syncthreads();
    {
        const int d = w >> 2, rt = (w >> 1) & 1, ct = w & 1;
        f32x4 acc = (f32x4){0.f, 0.f, 0.f, 0.f};
#pragma unroll
        for (int ks = 0; ks < 4; ++ks) {
            const bf16x8 a = *(const bf16x8*)(qeL + (d * 32 + rt * 16 + r16) * 136 + ks * 32 + quad * 8);
            const bf16x8 bb = *(const bf16x8*)(keL + (d * 32 + ct * 16 + r16) * 136 + ks * 32 + quad * 8);
            acc = MFMA16(a, bb, acc);
        }
#pragma unroll
        for (int reg = 0; reg < 4; ++reg) {
            const int cc = rt * 16 + quad * 4 + reg, ee = ct * 16 + r16;
            const bool keep = d ? (ee >= cc) : (ee <= cc);
            attL[(d * 32 + cc) * 40 + ee] = f2bf(keep ? acc[reg] : 0.f);
        }
    }
    __syncthreads();
    {
        const int d = w >> 2;
        bf16_t* Od = Ob + (size_t)d * MT * 512;
#pragma unroll
        for (int q4 = 0; q4 < 4; ++q4) {
            const int ti = (w & 3) * 4 + q4, rt = ti >> 3, dvt = ti & 7;
            const bf16x8 a = *(const bf16x8*)(attL + (d * 32 + rt * 16 + r16) * 40 + quad * 8);
            const bf16x8 bb = *(const bf16x8*)(vT + (dvt * 16 + r16) * 40 + quad * 8);
            const f32x4 o = MFMA16(bb, a, ((f32x4){0.f, 0.f, 0.f, 0.f}));
            u32x2 ow; ow.x = pk2(o[0], o[1]); ow.y = pk2(o[2], o[3]);
            *(u32x2*)(Od + (row0 + rt * 16 + r16) * 512 + h * 128 + dvt * 16 + quad * 4) = ow;
        }
    }
    __syncthreads();
}

struct HgShared { u32x4 rq, rk; float rd; };
struct HgPriv { u32x4 rv; u32x2 oin[2]; };
DI void hgrn_seq(const Prm& P, int it, unsigned char* lds) {
    const int tid = tid_now(), lane = tid & 63, w = tid >> 6, r16 = lane & 15, quad = lane >> 4;
    const int dir = it & 1, h = (it >> 1) & 3, b = it >> 3;
    bf16_t* STw = (bf16_t*)(lds + 38912) + w * (16 * 136);
    const unsigned char* PfB = P.ws + WS_PF; const unsigned char* PbB = P.ws + WS_BIG;
    bf16_t* Od = (bf16_t*)(P.ws + WS_M) + (size_t)dir * MT * 512;
    const int qrow = tid >> 4, qpc = tid & 15, kdk = tid >> 2, kpc = tid & 3, dvl = 16 * w + r16;
    for (int i = lane; i < 16 * 136; i += 64) STw[i] = 0;
    f32x4 Sacc[8];
#pragma unroll
    for (int i = 0; i < 8; ++i) Sacc[i] = (f32x4){0.f, 0.f, 0.f, 0.f};
    auto load_sh = [&](int n, HgShared& s) {
        const size_t row0 = (size_t)b * SEQ + (dir ? 63 - n : n) * 32;
        s.rq = *(const u32x4*)(PfB + (row0 + qrow) * 4096 + dir * 2048 + h * 512 + qpc * 16);
        s.rk = *(const u32x4*)(PfB + (row0 + (kdk >> 2)) * 4096 + dir * 2048 + h * 512 + 256 + (kdk & 3) * 64 + kpc * 16);
        s.rd = (tid < 128) ? *(const float*)(PbB + (row0 + dir * 2 + (tid >> 6)) * 5120 + (1024 + h * 128) * 2 + (tid & 63) * 4) : 0.f;
    };
    auto load_pr = [&](int n, HgPriv& p) {
        const size_t row0 = (size_t)b * SEQ + (dir ? 63 - n : n) * 32;
        p.rv = *(const u32x4*)(PbB + (row0 + (dvl >> 2)) * 5120 + (1536 + h * 128) * 2 + (dvl & 3) * 64 + quad * 16);
#pragma unroll
        for (int rt = 0; rt < 2; ++rt) p.oin[rt] = *(const u32x2*)(Od + (row0 + rt * 16 + r16) * 512 + h * 128 + 16 * w + quad * 4);
    };
    auto store_sh = [&](int st, const HgShared& s) {
        unsigned char* base = lds + st * 19456;
        *(u32x4*)(base + (qrow * 136 + qpc * 8) * 2) = s.rq;
        *(u32x4*)(base + 8704 + (kdk * 40 + kpc * 8) * 2) = s.rk;
        if (tid < 128) *(float*)(base + 18944 + tid * 4) = s.rd;
    };
    HgShared X, Y; HgPriv cur, PX, PY;
    load_sh(0, X); load_pr(0, cur); store_sh(0, X);
    load_sh(1, X); load_pr(1, PX);
    Y = X; PY = PX;
    __syncthreads();
    for (int n = 0; n < 64; ++n) {
        if (n + 2 < 64) { load_sh(n + 2, Y); load_pr(n + 2, PY); }
        const unsigned char* base = lds + (n & 1) * 19456;
        const bf16_t* QE = (const bf16_t*)base; const bf16_t* KT = (const bf16_t*)(base + 8704); const float* DEC = (const float*)(base + 18944);
        const size_t row0 = (size_t)b * SEQ + (dir ? 63 - n : n) * 32;
        __builtin_amdgcn_s_setprio(1);
        bf16x8 sb[4];
#pragma unroll
        for (int ks = 0; ks < 4; ++ks) sb[ks] = *(const bf16x8*)(STw + r16 * 136 + ks * 32 + quad * 8);
#pragma unroll
        for (int rt = 0; rt < 2; ++rt) {
            f32x4 o = (f32x4){0.f, 0.f, 0.f, 0.f};
#pragma unroll
            for (int ks = 0; ks < 4; ++ks) {
                const bf16x8 qa = *(const bf16x8*)(QE + (rt * 16 + r16) * 136 + ks * 32 + quad * 8);
                o = MFMA16(sb[ks], qa, o);
            }
            const u32x2 oi = cur.oin[rt];
            u32x2 ow; ow.x = pk2(o[0] + bflo(oi.x), o[1] + bfhi(oi.x)); ow.y = pk2(o[2] + bflo(oi.y), o[3] + bfhi(oi.y));
            *(u32x2*)(Od + (row0 + rt * 16 + r16) * 512 + h * 128 + 16 * w + quad * 4) = ow;
        }
        const bf16x8 vb = __builtin_bit_cast(bf16x8, cur.rv);
#pragma unroll
        for (int dkt = 0; dkt < 8; ++dkt) {
            const f32x4 dv4 = *(const f32x4*)(DEC + dkt * 16 + quad * 4);
            const bf16x8 ka = *(const bf16x8*)(KT + (dkt * 16 + r16) * 40 + quad * 8);
            Sacc[dkt] = MFMA16(ka, vb, Sacc[dkt] * dv4);
            u32x2 sp; sp.x = pk2(Sacc[dkt][0], Sacc[dkt][1]); sp.y = pk2(Sacc[dkt][2], Sacc[dkt][3]);
            *(u32x2*)(STw + r16 * 136 + dkt * 16 + quad * 4) = sp;
        }
        __builtin_amdgcn_s_setprio(0);
        if (n + 1 < 64) store_sh((n + 1) & 1, X);
        __syncthreads();
        X = Y; cur = PX; PX = PY;
    }
}

DI void hgrn_finish(const Prm& P, int r) {
    const int tid_ = tid_now(); const int lane = tid_ & 63, w = tid_ >> 6;
    const bf16_t* O0 = (const bf16_t*)(P.ws + WS_M); const bf16_t* O1 = O0 + (size_t)MT * 512;
    const bf16_t* Pb = (const bf16_t*)(P.ws + WS_BIG);
    bf16_t* Y = (bf16_t*)P.out;
    const float* ng = P.hgrn_norm_g + r * 512;
    const int c0 = lane * 8;
    for (int row = blockIdx.x * 8 + w; row < MT; row += gridDim.x * 8) {
        const u32x4 a = *(const u32x4*)(O0 + (size_t)row * 512 + c0), bq = *(const u32x4*)(O1 + (size_t)row * 512 + c0);
        const u32x4 gq = *(const u32x4*)(Pb + (size_t)row * 2560 + 2048 + c0);
        float o[8], g[8];
#pragma unroll
        for (int j = 0; j < 4; ++j) {
            o[2 * j] = bflo(a[j]) + bflo(bq[j]); o[2 * j + 1] = bfhi(a[j]) + bfhi(bq[j]);
            g[2 * j] = bflo(gq[j]); g[2 * j + 1] = bfhi(gq[j]);
        }
        float ss = 0.f;
#pragma unroll
        for (int j = 0; j < 8; ++j) ss += o[j] * o[j];
        ss += __shfl_xor(ss, 1); ss += __shfl_xor(ss, 2); ss += __shfl_xor(ss, 4); ss += __shfl_xor(ss, 8);
        const float rn = rsqrtf(ss * (1.0f / 128.0f) + EPSF);
        float y[8];
#pragma unroll
        for (int j = 0; j < 8; ++j) y[j] = o[j] * rn * ng[c0 + j] * (g[j] * sigm(g[j]));
        u32x4 q; q.x = pk2(y[0], y[1]); q.y = pk2(y[2], y[3]); q.z = pk2(y[4], y[5]); q.w = pk2(y[6], y[7]);
        *(u32x4*)(Y + (size_t)row * 1024 + 512 + c0) = q;
    }
}

DI float rcpf_(float x) { return __builtin_amdgcn_rcpf(x); }
DI float sigm_fast(float x) { return rcpf_(1.0f + __expf(-x)); }
template <int PASS>
DI void rg_loop(const Prm& P, int r, int h, int idx0, int stride, unsigned char* lds) {
    const int tid = tid_now(), lane = tid & 63, w = tid >> 6, r16 = lane & 15, quad = lane >> 4;
    constexpr int RS = 132;
    float* xcf = (float*)lds;
    bf16_t* xcb = (bf16_t*)(lds + 33792);
    bf16_t* Aa = (bf16_t*)(lds + 51200);
    bf16_t* Uu = (bf16_t*)(lds + 86016);
    float* carr = (float*)(lds + 120832);
    const bf16_t* Pb = (const bf16_t*)(P.ws + WS_BIG);
    unsigned long long* agg = (unsigned long long*)(P.ws + WS_AGG);
    const float* rgc = (const float*)(P.ws + WS_LB + 8192);
    bf16_t* Y = (bf16_t*)P.out;
    const int ch = tid & 127, tg = tid >> 7;
    const int tgu = __builtin_amdgcn_readfirstlane(w) >> 1;
    const bf16_t* Wg = (const bf16_t*)(P.ws + WS_WG) + (size_t)h * 512 * 128;
    bf16x8 wb[4][4];
#pragma unroll
    for (int ks = 0; ks < 4; ++ks)
#pragma unroll
        for (int ct = 0; ct < 4; ++ct) wb[ks][ct] = *(const bf16x8*)(Wg + (size_t)(w * 64 + ct * 16 + r16) * 128 + ks * 32 + quad * 8);
    float ecn[2][3];
    {
        const int dir = w >> 2;
#pragma unroll
        for (int ctl = 0; ctl < 2; ++ctl) {
            const int c = h * 128 + (w & 3) * 32 + ctl * 16 + r16;
#pragma unroll
            for (int q = 0; q < 3; ++q) ecn[ctl][q] = rgc[((r * 2 + dir) * 512 + c) * 3 + q];
        }
    }
    float cw[4];
#pragma unroll
    for (int k = 0; k < 4; ++k) cw[k] = P.rec_conv_w[(r * 4 + k) * 512 + h * 128 + ch];
    const float cb = P.rec_conv_b[r * 512 + h * 128 + ch];
    float xnx[19];
    auto load_xin = [&](int idx) {
        const int cn = idx & 31, b = idx >> 5;
#pragma unroll
        for (int j = 0; j < 19; ++j) {
            const int tt = cn * 64 + tgu * 16 + j - 2;
            const int tc = tt < 0 ? 0 : (tt >= SEQ ? SEQ - 1 : tt);
            const float v = bf2f(Pb[((size_t)b * SEQ + tc) * 2560 + h * 128 + ch]);
            xnx[j] = (tt >= 0 && tt < SEQ) ? v : 0.f;
        }
    };
    if (idx0 < 256) load_xin(idx0);
    for (int it = idx0; it < 256; it += stride) {
        const int cn = it & 31, b = it >> 5;
        const size_t abase = (size_t)((b * 4 + h) * 32);
        float gav[16];
        unsigned long long fe[16];
        const int wu = __builtin_amdgcn_readfirstlane(w);
        const int fdir = (wu >> 1) & 1, fhalf = wu >> 2, fc = tid & 127;
        const int fm = fdir ? 31 - cn : cn, fm0 = fm >> 1;
        const int fcnt = fhalf ? fm - fm0 : fm0, ffirst = fhalf ? fm0 : 0;
        if (PASS == 2) {
#pragma unroll
            for (int i = 0; i < 16; ++i) {
                const int ii = (i < fcnt) ? (ffirst + i) : 0;
                const int k = fdir ? 31 - ii : ii;
                fe[i] = agg[((abase + k) * 2 + fdir) * 128 + fc];
            }
        }
#pragma unroll
        for (int j = 0; j < 16; ++j) {
            const int i = tg * 16 + j;
            const float a = cb + cw[0] * xnx[j] + cw[1] * xnx[j + 1] + cw[2] * xnx[j + 2] + cw[3] * xnx[j + 3];
            xcf[i * RS + ch] = a; xcb[i * 136 + ch] = f2bf(a);
        }
        { const int itn = it + stride; load_xin(itn < 256 ? itn : it); }
        __syncthreads();
        if (PASS == 2) {
            float pp = 1.f, hh = 0.f;
#pragma unroll
            for (int i = 0; i < 16; ++i) {
                const float ex = (i < fcnt) ? __uint_as_float((unsigned)fe[i]) : 1.0f, ey = (i < fcnt) ? __uint_as_float((unsigned)(fe[i] >> 32)) : 0.0f;
                hh = ex * hh + ey; pp *= ex;
            }
            carr[(fhalf * 256 + (tid & 255)) * 2] = pp; carr[(fhalf * 256 + (tid & 255)) * 2 + 1] = hh;
        }
#pragma unroll 1
        for (int hf = 0; hf < 2; ++hf) {
            const int r0 = hf * 32;
            f32x4 acc[2][4];
#pragma unroll
            for (int rt = 0; rt < 2; ++rt)
#pragma unroll
                for (int ct = 0; ct < 4; ++ct) acc[rt][ct] = (f32x4){0.f, 0.f, 0.f, 0.f};
            __builtin_amdgcn_s_setprio(1);
#pragma unroll
            for (int ks = 0; ks < 4; ++ks) {
                bf16x8 xa[2];
#pragma unroll
                for (int rt = 0; rt < 2; ++rt) xa[rt] = *(const bf16x8*)(xcb + (r0 + rt * 16 + r16) * 136 + ks * 32 + quad * 8);
#pragma unroll
                for (int ct = 0; ct < 4; ++ct)
#pragma unroll
                    for (int rt = 0; rt < 2; ++rt) acc[rt][ct] = MFMA16(xa[rt], wb[ks][ct], acc[rt][ct]);
            }
            __builtin_amdgcn_s_setprio(0);
            const int dir = w >> 2;
#pragma unroll
            for (int ctl = 0; ctl < 2; ++ctl) {
                const int j = (w & 3) * 32 + ctl * 16 + r16;
                const float br = ecn[ctl][0], bi = ecn[ctl][1], sp8 = ecn[ctl][2];
#pragma unroll
                for (int rt = 0; rt < 2; ++rt)
#pragma unroll
                    for (int reg = 0; reg < 4; ++reg) {
                        const int i = r0 + rt * 16 + quad * 4 + reg;
                        const float er = 1.0f + __expf(fminf(-(acc[rt][ctl][reg] + br), 40.0f)), ei = 1.0f + __expf(fminf(-(acc[rt][ctl + 2][reg] + bi), 40.0f));
                        const float rc2 = rcpf_(er * ei);
                        const float rr = rc2 * ei, ii = rc2 * er;
                        const float a = __expf(rr * sp8);
                        const float u = __builtin_amdgcn_sqrtf(fmaxf(1.0f - a * a, 0.f)) * ii * xcf[i * RS + j];
                        Aa[(dir * 64 + i) * 136 + j] = f2bf(1.0f - a); Uu[(dir * 64 + i) * 136 + j] = f2bf(u);
                    }
            }
        }
        __syncthreads();
        if (PASS == 2) {
#pragma unroll
            for (int j = 0; j < 16; ++j) gav[j] = bf2f(Pb[((size_t)b * SEQ + cn * 64 + tgu * 16 + j) * 2560 + 512 + h * 128 + ch]);
        }
        if (tid < 256) {
            const int dir = tid >> 7, c = tid & 127;
            if (PASS == 1) {
                float pp = 1.f, hh = 0.f;
#pragma unroll 8
                for (int s = 0; s < 64; ++s) {
                    const int i = dir ? 63 - s : s;
                    const float a = 1.0f - bf2f(Aa[(dir * 64 + i) * 136 + c]), u = bf2f(Uu[(dir * 64 + i) * 136 + c]);
                    hh = a * hh + u; pp *= a;
                }
                agg[((abase + cn) * 2 + dir) * 128 + c] = ((unsigned long long)__float_as_uint(hh) << 32) | __float_as_uint(pp);
            } else {
                float hc = carr[(256 + tid) * 2] * carr[tid * 2 + 1] + carr[(256 + tid) * 2 + 1];
#pragma unroll 8
                for (int s = 0; s < 64; ++s) {
                    const int i = dir ? 63 - s : s;
                    const float a = 1.0f - bf2f(Aa[(dir * 64 + i) * 136 + c]), u = bf2f(Uu[(dir * 64 + i) * 136 + c]);
                    hc = a * hc + u; Uu[(dir * 64 + i) * 136 + c] = f2bf(hc);
                }
            }
        }
        if (PASS == 2) {
            __syncthreads();
#pragma unroll
            for (int j = 0; j < 16; ++j) {
                const int i = tgu * 16 + j, t = cn * 64 + i; const size_t row = (size_t)b * SEQ + t;
                const float ga = gav[j];
                const float inner = 0.7978845608028654f * (ga + 0.044715f * ga * ga * ga);
                const float th = 1.0f - 2.0f * rcpf_(__expf(2.0f * inner) + 1.0f);
                const float gl = 0.5f * ga * (1.0f + th);
                Y[row * 1024 + h * 128 + ch] = f2bf(gl * (bf2f(Uu[i * 136 + ch]) + bf2f(Uu[(64 + i) * 136 + ch])));
            }
        }
        __syncthreads();
    }
}

template <int CTRL> DI float dppf(float v) { return __builtin_bit_cast(float, __builtin_amdgcn_update_dpp(0, __builtin_bit_cast(int, v), CTRL, 0xf, 0xf, false)); }
DI float row16_max(float v) { v = fmaxf(v, dppf<0xB1>(v)); v = fmaxf(v, dppf<0x4E>(v)); v = fmaxf(v, dppf<0x124>(v)); v = fmaxf(v, dppf<0x128>(v)); return v; }
DI float row16_sum(float v) { v += dppf<0xB1>(v); v += dppf<0x4E>(v); v += dppf<0x124>(v); v += dppf<0x128>(v); return v; }
DI void att_item(const Prm& P, int al, int it, unsigned char* lds) {
    constexpr float QSC = 0.125f * 1.4426950408889634f;
    const int tid = tid_now(), lane = tid & 63, w = tid >> 6, r16 = lane & 15, quad = lane >> 4;
    const int gh = it & 1, n = (it >> 1) & 15, kvh = (it >> 5) & 3, b = it >> 7;
    bf16_t* Ks = (bf16_t*)lds;
    bf16_t* VT = (bf16_t*)(lds + 55296);
    bf16_t* Pw = (bf16_t*)(lds + 105472) + w * (32 * 72);
    const bf16_t* QKV = (const bf16_t*)(P.ws + WS_BIG);
    const float* rc = (const float*)(P.ws + WS_ROPE); const float* rsn = rc + 2048 * 32;
    bf16_t* Oo = (bf16_t*)P.out;
    const int k_lo = (n * 128 - 128) < 0 ? 0 : (n * 128 - 128);
    const int k_hi = (n * 128 + 256) > SEQ ? SEQ : (n * 128 + 256);
    const int nk = k_hi - k_lo;
    for (int task = tid; task < nk * 4; task += 512) {
        const int key = task >> 2, dg = task & 3, pos = k_lo + key;
        const bf16_t* src = QKV + ((size_t)b * SEQ + pos) * 1536 + 1024 + kvh * 64 + dg * 8;
        const u32x4 lo = *(const u32x4*)src, hi = *(const u32x4*)(src + 32);
        const f32x4 c0 = *(const f32x4*)(rc + pos * 32 + dg * 8), c1 = *(const f32x4*)(rc + pos * 32 + dg * 8 + 4);
        const f32x4 s0 = *(const f32x4*)(rsn + pos * 32 + dg * 8), s1 = *(const f32x4*)(rsn + pos * 32 + dg * 8 + 4);
        float x1[8], x2[8], o1[8], o2[8];
#pragma unroll
        for (int j = 0; j < 4; ++j) { x1[2 * j] = bflo(lo[j]); x1[2 * j + 1] = bfhi(lo[j]); x2[2 * j] = bflo(hi[j]); x2[2 * j + 1] = bfhi(hi[j]); }
#pragma unroll
        for (int j = 0; j < 8; ++j) {
            const float cs = j < 4 ? c0[j & 3] : c1[j & 3], sn = j < 4 ? s0[j & 3] : s1[j & 3];
            o1[j] = x1[j] * cs - x2[j] * sn; o2[j] = x2[j] * cs + x1[j] * sn;
        }
        u32x4 w1, w2;
        w1.x = pk2(o1[0], o1[1]); w1.y = pk2(o1[2], o1[3]); w1.z = pk2(o1[4], o1[5]); w1.w = pk2(o1[6], o1[7]);
        w2.x = pk2(o2[0], o2[1]); w2.y = pk2(o2[2], o2[3]); w2.z = pk2(o2[4], o2[5]); w2.w = pk2(o2[6], o2[7]);
        *(u32x4*)(Ks + key * 72 + dg * 8) = w1;
        *(u32x4*)(Ks + key * 72 + 32 + dg * 8) = w2;
    }
    for (int task = tid; task < nk * 4; task += 512) {
        const int kp = task >> 3, dg = task & 7, pos = k_lo + 2 * kp;
        const bf16_t* src = QKV + ((size_t)b * SEQ + pos) * 1536 + 1280 + kvh * 64 + dg * 8;
        const u32x4 va = *(const u32x4*)src, vb2 = *(const u32x4*)(src + 1536);
#pragma unroll
        for (int j = 0; j < 4; ++j) {
            *(unsigned*)(VT + (dg * 8 + 2 * j) * 392 + 2 * kp) = (va[j] & 0xffffu) | (vb2[j] << 16);
            *(unsigned*)(VT + (dg * 8 + 2 * j + 1) * 392 + 2 * kp) = (va[j] >> 16) | (vb2[j] & 0xffff0000u);
        }
    }
    const int hq = kvh * 4 + gh * 2 + (w >> 2), qrow0 = n * 128 + (w & 3) * 32;
    bf16x8 qa[2][2];
#pragma unroll
    for (int rt = 0; rt < 2; ++rt) {
        const int pos = qrow0 + rt * 16 + r16;
        const bf16_t* src = QKV + ((size_t)b * SEQ + pos) * 1536 + hq * 64 + quad * 8;
        const u32x4 lo = *(const u32x4*)src, hi = *(const u32x4*)(src + 32);
        const f32x4 c0 = *(const f32x4*)(rc + pos * 32 + quad * 8), c1 = *(const f32x4*)(rc + pos * 32 + quad * 8 + 4);
        const f32x4 s0 = *(const f32x4*)(rsn + pos * 32 + quad * 8), s1 = *(const f32x4*)(rsn + pos * 32 + quad * 8 + 4);
        float x1[8], x2[8], o1[8], o2[8];
#pragma unroll
        for (int j = 0; j < 4; ++j) { x1[2 * j] = bflo(lo[j]); x1[2 * j + 1] = bfhi(lo[j]); x2[2 * j] = bflo(hi[j]); x2[2 * j + 1] = bfhi(hi[j]); }
#pragma unroll
        for (int j = 0; j < 8; ++j) {
            const float cs = j < 4 ? c0[j & 3] : c1[j & 3], sn = j < 4 ? s0[j & 3] : s1[j & 3];
            o1[j] = (x1[j] * cs - x2[j] * sn) * QSC; o2[j] = (x2[j] * cs + x1[j] * sn) * QSC;
        }
        u32x4 w1, w2;
        w1.x = pk2(o1[0], o1[1]); w1.y = pk2(o1[2], o1[3]); w1.z = pk2(o1[4], o1[5]); w1.w = pk2(o1[6], o1[7]);
        w2.x = pk2(o2[0], o2[1]); w2.y = pk2(o2[2], o2[3]); w2.z = pk2(o2[4], o2[5]); w2.w = pk2(o2[6], o2[7]);
        qa[rt][0] = __builtin_bit_cast(bf16x8, w1); qa[rt][1] = __builtin_bit_cast(bf16x8, w2);
    }
    const float sink = P.att_sinks[al * 16 + hq] * 1.4426950408889634f;
    float mq[2], lq[2];
    f32x4 o[4][2];
#pragma unroll
    for (int qt = 0; qt < 2; ++qt) {
        mq[qt] = sink; lq[qt] = (quad == 0) ? 1.0f : 0.0f;
#pragma unroll
        for (int dt = 0; dt < 4; ++dt) o[dt][qt] = (f32x4){0.f, 0.f, 0.f, 0.f};
    }
    __syncthreads();
    const int nkc = nk >> 6;
    for (int kc = 0; kc < nkc; ++kc) {
        const int kmin = k_lo + kc * 64;
        if (kmin + 63 < qrow0 - 128 || kmin > qrow0 + 31 + 128) continue;
        const bool interior = (kmin >= qrow0 + 31 - 128) && (kmin + 63 <= qrow0 + 128);
        f32x4 s[4][2];
#pragma unroll
        for (int kt = 0; kt < 4; ++kt)
#pragma unroll
            for (int qt = 0; qt < 2; ++qt) s[kt][qt] = (f32x4){0.f, 0.f, 0.f, 0.f};
        __builtin_amdgcn_s_setprio(1);
#pragma unroll
        for (int ks = 0; ks < 2; ++ks)
#pragma unroll
            for (int kt = 0; kt < 4; ++kt) {
                const bf16x8 ka = *(const bf16x8*)(Ks + (kc * 64 + kt * 16 + r16) * 72 + ks * 32 + quad * 8);
#pragma unroll
                for (int qt = 0; qt < 2; ++qt) s[kt][qt] = MFMA16(ka, qa[qt][ks], s[kt][qt]);
            }
        __builtin_amdgcn_s_setprio(0);
#pragma unroll
        for (int qt = 0; qt < 2; ++qt) {
            const int qpos = qrow0 + qt * 16 + r16;
            float mx = -1e30f;
            if (interior) {
#pragma unroll
                for (int kt = 0; kt < 4; ++kt)
#pragma unroll
                    for (int reg = 0; reg < 4; ++reg) mx = fmaxf(mx, s[kt][qt][reg]);
            } else {
#pragma unroll
                for (int kt = 0; kt < 4; ++kt)
#pragma unroll
                    for (int reg = 0; reg < 4; ++reg) {
                        const int d = qpos - (kmin + kt * 16 + quad * 4 + reg);
                        const float sv = (d <= 128 && d >= -128) ? s[kt][qt][reg] : -1e30f;
                        s[kt][qt][reg] = sv; mx = fmaxf(mx, sv);
                    }
            }
            mx = fmaxf(mx, __shfl_xor(mx, 16)); mx = fmaxf(mx, __shfl_xor(mx, 32));
            const float mn = fmaxf(mq[qt], mx), alpha = __builtin_amdgcn_exp2f(mq[qt] - mn);
            mq[qt] = mn;
            float ps = 0.f;
#pragma unroll
            for (int kt = 0; kt < 4; ++kt) {
                const float p0 = __builtin_amdgcn_exp2f(s[kt][qt][0] - mn), p1 = __builtin_amdgcn_exp2f(s[kt][qt][1] - mn);
                const float p2 = __builtin_amdgcn_exp2f(s[kt][qt][2] - mn), p3 = __builtin_amdgcn_exp2f(s[kt][qt][3] - mn);
                ps += (p0 + p1) + (p2 + p3);
                u32x2 pw; pw.x = pk2(p0, p1); pw.y = pk2(p2, p3);
                *(u32x2*)(Pw + (qt * 16 + r16) * 72 + kt * 16 + quad * 4) = pw;
            }
            lq[qt] = lq[qt] * alpha + ps;
#pragma unroll
            for (int dt = 0; dt < 4; ++dt) o[dt][qt] = o[dt][qt] * alpha;
        }
        asm volatile("s_waitcnt lgkmcnt(0)" ::: "memory");
        __builtin_amdgcn_s_setprio(1);
#pragma unroll
        for (int ks = 0; ks < 2; ++ks) {
            bf16x8 pb[2];
#pragma unroll
            for (int qt = 0; qt < 2; ++qt) pb[qt] = *(const bf16x8*)(Pw + (qt * 16 + r16) * 72 + ks * 32 + quad * 8);
#pragma unroll
            for (int dt = 0; dt < 4; ++dt) {
                const bf16x8 va = *(const bf16x8*)(VT + (dt * 16 + r16) * 392 + kc * 64 + ks * 32 + quad * 8);
#pragma unroll
                for (int qt = 0; qt < 2; ++qt) o[dt][qt] = MFMA16(va, pb[qt], o[dt][qt]);
            }
        }
        __builtin_amdgcn_s_setprio(0);
        asm volatile("s_waitcnt lgkmcnt(0)" ::: "memory");
    }
#pragma unroll
    for (int qt = 0; qt < 2; ++qt) {
        float l = lq[qt];
        l += __shfl_xor(l, 16); l += __shfl_xor(l, 32);
        const float inv = __builtin_amdgcn_rcpf(l);
        const int pos = qrow0 + qt * 16 + r16;
#pragma unroll
        for (int dt = 0; dt < 4; ++dt) {
            const f32x4 ov = o[dt][qt] * inv;
            u32x2 ow; ow.x = pk2(ov[0], ov[1]); ow.y = pk2(ov[2], ov[3]);
            *(u32x2*)(Oo + ((size_t)b * SEQ + pos) * 1024 + hq * 64 + dt * 16 + quad * 4) = ow;
        }
    }
    __syncthreads();
}

#define XB_TMO      128
#define XB_XCNT(j)  (256  + 64 * (j))
#define XB_XSUB(j)  (1280 + 64 * (j))
#define XB_XGEN(j)  (2304 + 64 * (j))
#define XB_TOP      3328
#define XB_TOPGEN   3392
#define XCD_BAR_WORDS 3456
#define XB_SPIN_CAP (1u << 18)

__device__ __forceinline__ unsigned xb_ld(unsigned* p)              { return __hip_atomic_load(p, __ATOMIC_RELAXED, __HIP_MEMORY_SCOPE_AGENT); }
__device__ __forceinline__ unsigned xb_add(unsigned* p, unsigned v) { return __hip_atomic_fetch_add(p, v, __ATOMIC_RELAXED, __HIP_MEMORY_SCOPE_AGENT); }
__device__ __forceinline__ unsigned xb_xcc_id() { return (unsigned)__builtin_amdgcn_s_getreg((3 << 11) | 20) & 0xFu; }
#define XB_SPIN(cond, bar) do { unsigned _sp = 0; while (cond) { __builtin_amdgcn_s_sleep(1); \
    if ((++_sp & 255u) == 0u) { if (xb_ld(&(bar)[XB_TMO])) break; if (_sp > XB_SPIN_CAP) { atomicAdd(&(bar)[XB_TMO], 1u); break; } } } } while (0)

struct XcdBarrier {
    unsigned* bar; unsigned x;
    volatile PG8_LAS unsigned* st;
};

__device__ __forceinline__ XcdBarrier xcd_barrier_post(unsigned* bar, volatile PG8_LAS unsigned* st) {
    XcdBarrier b; b.bar = bar; b.x = xb_xcc_id(); b.st = st;
    if (threadIdx.x == 0) (void)xb_add(&bar[XB_XCNT(b.x)], 1u);
    return b;
}
__device__ __forceinline__ void xcd_barrier_complete(unsigned* bar, unsigned x, unsigned& nloc, unsigned& nx) {
    const unsigned G = gridDim.x * gridDim.y * gridDim.z;
    unsigned sum, cnt, mine, sp = 0u;
    for (;;) {
        sum = 0u; cnt = 0u; mine = 0u;
#pragma unroll
        for (unsigned j = 0; j < 16; ++j) { const unsigned c = xb_ld(&bar[XB_XCNT(j)]); sum += c; cnt += (c > 0u) ? 1u : 0u; mine = (j == x) ? c : mine; }
        if (sum == G) break;
        __builtin_amdgcn_s_sleep(1);
        if ((++sp & 255u) == 0u) { if (xb_ld(&bar[XB_TMO])) break; if (sp > XB_SPIN_CAP) { atomicAdd(&bar[XB_TMO], 1u); break; } }
    }
    nloc = mine > 0u ? mine : 1u; nx = cnt > 0u ? cnt : 1u;
}

__device__ __forceinline__ void xcd_barrier(const XcdBarrier& b) {
    asm volatile("s_waitcnt vmcnt(0)" ::: "memory");
    __syncthreads();
    if (threadIdx.x == 0) {
        unsigned* bar = b.bar;
        __builtin_amdgcn_s_waitcnt(0);
        unsigned nloc = b.st[0], nx = b.st[1];
        if (nloc == 0u) { xcd_barrier_complete(bar, b.x, nloc, nx); b.st[0] = nloc; b.st[1] = nx; }
        const unsigned old = xb_add(&bar[XB_XSUB(b.x)], 1u);
        const unsigned gen = old / nloc;
        if (old + 1u == (gen + 1u) * nloc) {
            __builtin_amdgcn_fence(__ATOMIC_RELEASE, "agent");
            asm volatile("s_waitcnt vmcnt(0)" ::: "memory");
            const unsigned og = xb_add(&bar[XB_TOP], 1u);
            const unsigned tg = og / nx;
            if (og + 1u == (tg + 1u) * nx) xb_add(&bar[XB_TOPGEN], 1u);
            else XB_SPIN(xb_ld(&bar[XB_TOPGEN]) == tg, bar);
            __builtin_amdgcn_fence(__ATOMIC_ACQUIRE, "agent");
            xb_add(&bar[XB_XGEN(b.x)], 1u);
            asm volatile("s_waitcnt vmcnt(0)" ::: "memory");
        } else {
            XB_SPIN(xb_ld(&bar[XB_XGEN(b.x)]) == gen, bar);
            __builtin_amdgcn_fence(__ATOMIC_ACQUIRE, "agent");
            asm volatile("s_waitcnt vmcnt(0)" ::: "memory");
        }
    }
    __syncthreads();
}


__global__ void __launch_bounds__(512, 2) fwd_kernel(Prm P0) {
    extern __shared__ __attribute__((aligned(16))) unsigned char lds[];
    cg::grid_group grid = cg::this_grid();
    const int G = gridDim.x, bid = blockIdx.x;
    const XcdBarrier xb = [&]() {
    const Prm& P = P0;
    unsigned char* ws = P.ws;
    unsigned* barw = (unsigned*)(ws + WS_BAR);
    volatile PG8_LAS unsigned* xst = (volatile PG8_LAS unsigned*)((PG8_LAS unsigned char*)lds + (LDS_BYTES - 16));
    if (threadIdx.x == 0) { xst[0] = 0u; xst[1] = 0u; }
    const XcdBarrier xb0 = xcd_barrier_post(barw, xst);
    if (P.x == nullptr) grid.sync();
    prep_phase(P, lds);
    xcd_barrier(xb0);
    return xb0;
    }();
    typedef const __attribute__((address_space(4))) Prm* KPrm;
    const KPrm kp0 = (KPrm)__builtin_amdgcn_kernarg_segment_ptr();
    for (int ph = 0; ph < 36; ++ph) {
        KPrm kp = kp0; asm volatile("" : "+s"(kp));
        Prm P;
        P.x = kp->x; P.norm_g = kp->norm_g; P.rec_w_in = kp->rec_w_in; P.rec_conv_w = kp->rec_conv_w; P.rec_conv_b = kp->rec_conv_b;
        P.rg_w_r = kp->rg_w_r; P.rg_b_r = kp->rg_b_r; P.rg_w_i = kp->rg_w_i; P.rg_b_i = kp->rg_b_i; P.rg_lambda = kp->rg_lambda;
        P.lb_logits = kp->lb_logits; P.hgrn_norm_g = kp->hgrn_norm_g; P.rec_w_out = kp->rec_w_out; P.att_w_qkv = kp->att_w_qkv; P.att_sinks = kp->att_sinks;
        P.att_w_o = kp->att_w_o; P.mlp_w1 = kp->mlp_w1; P.mlp_w2 = kp->mlp_w2; P.out = kp->out; P.ws = kp->ws;
        unsigned char* ws = P.ws;
        const int layer = ph / 9, slot = ph - layer * 9;
        const bool rec = (layer & 1) == 0;
        const int li = layer >> 1;
        const float* g = P.norm_g + (size_t)layer * 4096;
        if (slot == 0 || slot == 4 || slot == 6 || slot == 7) {
            pg8::Gemm gm; Epi E;
            E.Pf = (float*)(ws + WS_PF); E.lbl = (const PG8_LAS float*)((PG8_LAS unsigned char*)lds + 131072);
            if (slot == 0 && rec) {
                const float* lbv = (const float*)(ws + WS_LB) + li * 1024;
                for (int i = threadIdx.x; i < 1024; i += 512) ((PG8_LAS float*)((PG8_LAS unsigned char*)lds + 131072))[i] = lbv[i];
                __syncthreads();
            }
            gm.M = MT;
            if (slot == 0) {
                gm.A = (const bf16_t*)(ws + WS_HB); gm.Bt = (const bf16_t*)(ws + WS_WA); gm.K = 1024;
                gm.N = rec ? 3584 : 1536; E.mode = rec ? 3 : 1; E.O = (bf16_t*)(ws + WS_BIG); E.ldc = rec ? 2560 : 1536;
            } else if (slot == 4) {
                gm.A = (const bf16_t*)P.out; gm.Bt = (const bf16_t*)(ws + WS_WB); gm.K = 1024; gm.N = 1024;
                E.mode = 0; E.O = (bf16_t*)(ws + WS_M); E.ldc = 1024;
            } else if (slot == 6) {
                gm.A = (const bf16_t*)(ws + WS_HB); gm.Bt = (const bf16_t*)(ws + WS_W1); gm.K = 1024; gm.N = 4096;
                E.mode = 2; E.O = (bf16_t*)(ws + WS_BIG); E.ldc = 4096;
            } else {
                gm.A = (const bf16_t*)(ws + WS_BIG); gm.Bt = (const bf16_t*)(ws + WS_W2); gm.K = 4096; gm.N = 1024;
                E.mode = 0; E.O = (bf16_t*)(ws + WS_M); E.ldc = 1024;
            }
            pg8::StaticOrder S; S.init(gm.M, gm.N, G, bid);
            pg8::gemm_phase<Epi, pg8::StaticOrder>((PG8_LAS unsigned char*)lds, gm, S, E);
            if (slot == 0) { __syncthreads(); if (G >= 256) { if (bid >= 128) conv_mlp(P, layer, lds, bid - 128, G - 128); } else conv_mlp(P, layer, lds, bid, G); }
        } else if (slot == 1) {
            if (rec) {
                for (int it = bid; it < 2048; it += G) hgrn_pre(P, it, lds);
                rg_loop<1>(P, li, bid & 3, bid >> 2, G >> 2, lds);
            } else {
                for (int it = bid; it < 1024; it += G) att_item(P, li, it, lds);
            }
        } else if (slot == 2) {
            if (!rec) continue;
            if (bid < 64) hgrn_seq(P, bid, lds);
            else rg_loop<2>(P, li, (bid - 64) & 3, (bid - 64) >> 2, (G - 64) >> 2, lds);
        } else if (slot == 3) {
            if (!rec) continue;
            hgrn_finish(P, li);
        } else if (slot == 5) {
            resnorm_phase((const bf16_t*)(ws + WS_M), (bf16_t*)(ws + WS_HB), (float*)(ws + WS_RS), g + 1024, nullptr);
        } else {
            resnorm_phase((const bf16_t*)(ws + WS_M), (bf16_t*)(ws + WS_HB), (float*)(ws + WS_RS), g + 3072, layer == 3 ? P.out : nullptr);
            if (layer < 3) conv_layer(P, layer + 1, lds);
        }
        xcd_barrier(xb);
    }
}

extern "C" void kernel_launch(void* const* d_in, const int* in_sizes, int n_in, void* d_out, int out_size, void* d_ws, size_t ws_size, hipStream_t stream) {
    static int grid_blocks = 0;
    if (!grid_blocks) {
        int dev = 0, cus = 0, per_cu = 0;
        hipGetDevice(&dev);
        hipDeviceGetAttribute(&cus, hipDeviceAttributeMultiprocessorCount, dev);
        hipFuncSetAttribute((const void*)fwd_kernel, hipFuncAttributeMaxDynamicSharedMemorySize, LDS_BYTES);
        hipOccupancyMaxActiveBlocksPerMultiprocessor(&per_cu, (const void*)fwd_kernel, 512, LDS_BYTES);
        if (per_cu < 1) per_cu = 1;
        grid_blocks = cus * 1;
        if (ws_size < WS_END) fprintf(stderr, "kernel_launch: workspace too small: %zu < %zu\n", ws_size, (size_t)WS_END);
        (void)hipGetLastError();
    }
    Prm p{};
    p.x = (const float*)d_in[0]; p.norm_g = (const float*)d_in[1]; p.rec_w_in = (const float*)d_in[2]; p.rec_conv_w = (const float*)d_in[3];
    p.rec_conv_b = (const float*)d_in[4]; p.rg_w_r = (const float*)d_in[5]; p.rg_b_r = (const float*)d_in[6]; p.rg_w_i = (const float*)d_in[7];
    p.rg_b_i = (const float*)d_in[8]; p.rg_lambda = (const float*)d_in[9]; p.lb_logits = (const float*)d_in[10]; p.hgrn_norm_g = (const float*)d_in[11];
    p.rec_w_out = (const float*)d_in[12]; p.att_w_qkv = (const float*)d_in[13]; p.att_sinks = (const float*)d_in[14]; p.att_w_o = (const float*)d_in[15];
    p.mlp_w1 = (const float*)d_in[16]; p.mlp_w2 = (const float*)d_in[17];
    p.out = (float*)d_out; p.ws = (unsigned char*)d_ws;
    (void)hipMemsetAsync((char*)d_ws + WS_BAR, 0, 16384 + 4096, stream);
    void* args[] = {&p};
    hipError_t e = hipLaunchCooperativeKernel((const void*)fwd_kernel, dim3(grid_blocks), dim3(512), args, LDS_BYTES, stream);
    if (e != hipSuccess) fprintf(stderr, "cooperative launch failed: %s (grid %d)\n", hipGetErrorString(e), grid_blocks);
}
```

```cpp
#include <hip/hip_runtime.h>
#include <hip/hip_cooperative_groups.h>
#include <cstdio>
namespace cg = cooperative_groups;
namespace pg8 {
#define PG8_LAS __attribute__((address_space(3)))
typedef unsigned short bf16_t;
typedef short bf16x8 __attribute__((ext_vector_type(8)));
typedef float f32x4 __attribute__((ext_vector_type(4)));
typedef unsigned u32x4 __attribute__((ext_vector_type(4)));
constexpr int BM = 256, BK = 64, HALF = 128, HTB = HALF * BK * 2  , STAGE_BYTES = 8 * HTB, NXCD = 8, WGM = 8;

__host__ __device__ __forceinline__ int lds_byte(int r, int c) { const int st = (r >> 4) * 2 + (c >> 5), rr = r & 15, cc = c & 31, ob = rr * 64 + cc * 2; return st * 1024 + (ob ^ (((ob >> 9) & 1) << 5)); }
__host__ __device__ __forceinline__ void stage_rc(int b, int& R, int& C) { const int st = b / 1024, sb = b % 1024, swz = sb ^ (((sb >> 9) & 1) << 5); R = (st >> 1) * 16 + swz / 64; C = (st & 1) * 32 + (swz % 64) / 2; }
__host__ __device__ __forceinline__ int perm32(int rho) { const int n = rho >> 4, i = rho & 15; return 8 * (i >> 2) + 4 * n + (i & 3); }

struct Unit { int pm, pn; };
struct Gemm { const bf16_t* A; const bf16_t* Bt; int M, N, K; };

struct StaticOrder {
    int nM, nN, nwg, G, c;
    __host__ __device__ void init(int M, int N, int G_, int c_) { nM = M / BM; nN = N / BM; nwg = nM * nN; G = G_; c = c_; }
    __host__ __device__ bool next(int i, Unit& u) const {
        const long L = (long)i * G + c; if (L >= nwg) return false;
        int wgid = (int)L; { const int q = nwg / NXCD, r = nwg % NXCD, xcd = wgid % NXCD, off = wgid / NXCD; wgid = (xcd < r ? xcd * (q + 1) : r * (q + 1) + (xcd - r) * q) + off; }
        const int nig = WGM * nN, gid = wgid / nig, fm = gid * WGM, gsz = (nM - fm) < WGM ? (nM - fm) : WGM;
        u.pm = fm + ((wgid % nig) % gsz); u.pn = (wgid % nig) / gsz; return true;
    }
    __device__ __forceinline__ void a_ready(const Unit&) const {}
    __device__ __forceinline__ void done(const Unit&) const {}
};

template <class Epi, class Sched, bool STAMP = false>
__device__ __forceinline__ void gemm_phase(PG8_LAS unsigned char* lds, const Gemm g, const Sched& S, const Epi& E, unsigned long long* stamps = nullptr) {
    int tid = threadIdx.x; asm volatile("" : "+v"(tid)); const int wid = __builtin_amdgcn_readfirstlane(tid >> 6), lane = tid & 63, wr = wid >> 2, wc = wid & 3, fr = lane & 15, fq = lane >> 4;
    const int K = g.K, nt = K / BK;
    int ts_lo = 0, ts_hi = 0, nts = 0; const unsigned long long rt_entry = STAMP ? (unsigned long long)wall_clock64() : 0ull;
#define PG8_STAMP() do { if (STAMP && wid == 0 && nts < 64) { const unsigned long long _c = (unsigned long long)clock64(); \
        ts_lo = (lane == nts) ? (int)(unsigned)_c : ts_lo; ts_hi = (lane == nts) ? (int)(unsigned)(_c >> 32) : ts_hi; ++nts; } } while (0)
    PG8_STAMP();
    unsigned voffA[2], voffB[2];
#pragma unroll
    for (int i = 0; i < 2; ++i) { int R, C; stage_rc(tid * 16 + i * 8192, R, C); const int Rb = Epi::PERM ? ((R & ~31) + perm32(R & 31)) : R;
        voffA[i] = (unsigned)(R * K + C) * 2u; voffB[i] = (unsigned)(Rb * K + C) * 2u; }
    const size_t kstep = (size_t)(BK * 2);
    const size_t hstep = (size_t)HALF * K * 2;
    const size_t tstep = 2 * hstep;
    const unsigned ldsw = (unsigned)wid * 1024u;
    const int aoff = lds_byte(wr * 64 + fr, fq * 8), boff = lds_byte(wc * 32 + fr, fq * 8);
#define PG8_SA(b, h) (((b) * 2 + (h)) * HTB)
#define PG8_SB(b, h) ((4 + (b) * 2 + (h)) * HTB)
#define PG8_STAGE(bufoff, gbase, voff) do { _Pragma("unroll") for (int _i = 0; _i < 2; ++_i) \
        __builtin_amdgcn_global_load_lds((const unsigned*)((const char*)(gbase) + (voff)[_i]), (PG8_LAS unsigned*)(lds + (bufoff) + ldsw + _i * 8192), 16, 0, 0); } while (0)
#define PG8_LDA(dst, b, h) do { _Pragma("unroll") for (int m = 0; m < 4; ++m) _Pragma("unroll") for (int k = 0; k < 2; ++k) dst[m][k] = *(const PG8_LAS bf16x8*)(lds + PG8_SA(b, h) + aoff + m * 2048 + k * 1024); } while (0)
#define PG8_LDB(dst, b, h) do { _Pragma("unroll") for (int n = 0; n < 2; ++n) _Pragma("unroll") for (int k = 0; k < 2; ++k) dst[n][k] = *(const PG8_LAS bf16x8*)(lds + PG8_SB(b, h) + boff + n * 2048 + k * 1024); } while (0)
#define PG8_MMA(ai, bj, At, Bt) do { __builtin_amdgcn_s_setprio(1); _Pragma("unroll") for (int m = 0; m < 4; ++m) _Pragma("unroll") for (int n = 0; n < 2; ++n) _Pragma("unroll") for (int k = 0; k < 2; ++k) \
        acc[ai][bj][m][n] = __builtin_amdgcn_mfma_f32_16x16x32_bf16(Bt[n][k], At[m][k], acc[ai][bj][m][n], 0, 0, 0); __builtin_amdgcn_s_setprio(0); } while (0)
#define PG8_WAIT_V(n) asm volatile("s_waitcnt vmcnt(" #n ")" ::: "memory")
#define PG8_WAIT_L(n) asm volatile("s_waitcnt lgkmcnt(" #n ")" ::: "memory")
#define PG8_BAR __builtin_amdgcn_s_barrier()
#define PG8_SCHED __builtin_amdgcn_sched_barrier(0)
    Unit cur, nxt; int ui = 0;
    if (!S.next(0, cur)) return;
    f32x4 acc[2][2][4][2];
#pragma unroll
    for (int a = 0; a < 2; ++a)
#pragma unroll
        for (int b = 0; b < 2; ++b)
#pragma unroll
            for (int m = 0; m < 4; ++m)
#pragma unroll
                for (int n = 0; n < 2; ++n) acc[a][b][m][n] = (f32x4){0.f, 0.f, 0.f, 0.f};
    bf16x8 At[4][2], B0[2][2], B1[2][2];
    const char* cA = (const char*)g.A + (size_t)cur.pm * tstep; const char* cB = (const char*)g.Bt + (size_t)cur.pn * tstep;
    S.a_ready(cur);
    PG8_STAGE(PG8_SB(0, 0), cB, voffB); PG8_STAGE(PG8_SA(0, 0), cA, voffA); PG8_STAGE(PG8_SB(0, 1), cB + hstep, voffB); PG8_STAGE(PG8_SA(0, 1), cA + hstep, voffA);
    if (wr == 1) PG8_BAR;
    PG8_WAIT_V(4); PG8_BAR;
    PG8_STAGE(PG8_SB(1, 0), cB + kstep, voffB); PG8_STAGE(PG8_SA(1, 0), cA + kstep, voffA); PG8_STAGE(PG8_SB(1, 1), cB + hstep + kstep, voffB);
    PG8_WAIT_V(6); PG8_BAR;
    PG8_STAMP();
    for (;;) {
        const bool has_next = S.next(ui + 1, nxt);
        const char* nA = has_next ? (const char*)g.A + (size_t)nxt.pm * tstep : cA; const char* nB = has_next ? (const char*)g.Bt + (size_t)nxt.pn * tstep : cB;
        for (int t = 0; t < nt; t += 2) {
            const bool last = (t == nt - 2);
            const char* a1 = cA + (size_t)(t + 1) * kstep;
            const char* a2 = last ? nA : cA + (size_t)(t + 2) * kstep; const char* b2 = last ? nB : cB + (size_t)(t + 2) * kstep;
            const char* a3 = a2 + kstep; const char* b3 = b2 + kstep;
            if (last && has_next) S.a_ready(nxt);
            PG8_LDB(B0, 0, 0); PG8_SCHED; PG8_LDA(At, 0, 0); PG8_STAGE(PG8_SA(1, 1), a1 + hstep, voffA);
            PG8_WAIT_L(8); PG8_BAR; PG8_WAIT_L(0); PG8_MMA(0, 0, At, B0); PG8_BAR; PG8_SCHED;
            PG8_LDB(B1, 0, 1); PG8_STAGE(PG8_SB(0, 0), b2, voffB);
            PG8_BAR; PG8_WAIT_L(0); PG8_MMA(0, 1, At, B1); PG8_BAR;
            PG8_LDA(At, 0, 1); PG8_STAGE(PG8_SA(0, 0), a2, voffA);
            PG8_BAR; PG8_WAIT_L(0); PG8_MMA(1, 0, At, B0); PG8_BAR; PG8_SCHED;
            PG8_STAGE(PG8_SB(0, 1), b2 + hstep, voffB);
            PG8_WAIT_V(6); PG8_BAR; PG8_MMA(1, 1, At, B1); PG8_BAR;
            PG8_LDB(B0, 1, 0); PG8_SCHED; PG8_LDA(At, 1, 0); PG8_STAGE(PG8_SA(0, 1), a2 + hstep, voffA);
            PG8_WAIT_L(8); PG8_BAR; PG8_WAIT_L(0); PG8_MMA(0, 0, At, B0); PG8_BAR; PG8_SCHED;
            PG8_LDB(B1, 1, 1); PG8_STAGE(PG8_SB(1, 0), b3, voffB);
            PG8_BAR; PG8_WAIT_L(0); PG8_MMA(0, 1, At, B1); PG8_BAR;
            PG8_LDA(At, 1, 1); PG8_STAGE(PG8_SA(1, 0), a3, voffA);
            PG8_BAR; PG8_WAIT_L(0); PG8_MMA(1, 0, At, B0); PG8_BAR; PG8_SCHED;
            PG8_STAGE(PG8_SB(1, 1), b3 + hstep, voffB);
            PG8_WAIT_V(6); PG8_BAR; PG8_MMA(1, 1, At, B1); PG8_BAR;
        }
        PG8_STAMP();
        if constexpr (!Epi::AFTER_DRAIN) { E(acc, cur, wr, wc, fr, fq); S.done(cur); }
        PG8_STAMP();
        if (!has_next) break;
#pragma unroll
        for (int a = 0; a < 2; ++a)
#pragma unroll
            for (int b = 0; b < 2; ++b)
#pragma unroll
                for (int m = 0; m < 4; ++m)
#pragma unroll
                    for (int n = 0; n < 2; ++n) acc[a][b][m][n] = (f32x4){0.f, 0.f, 0.f, 0.f};
        cur = nxt; cA = nA; cB = nB; ++ui;
    }
    PG8_WAIT_V(0);
    if (wr == 0) PG8_BAR;
    PG8_BAR;
    if constexpr (Epi::AFTER_DRAIN) { E.fused(acc, cur, wr, wc, fr, fq, lds, wid, lane); S.done(cur); }
    PG8_STAMP();
    if (STAMP && wid == 0) { stamps[lane] = lane < nts ? (((unsigned long long)(unsigned)ts_hi << 32) | (unsigned)ts_lo) : 0ull;
        if (lane == 62) stamps[62] = rt_entry; if (lane == 63) stamps[63] = (unsigned long long)wall_clock64(); }
#undef PG8_STAMP
#undef PG8_SA
#undef PG8_SB
#undef PG8_STAGE
#undef PG8_LDA
#undef PG8_LDB
#undef PG8_MMA
#undef PG8_WAIT_V
#undef PG8_WAIT_L
#undef PG8_BAR
#undef PG8_SCHED
}
}


using pg8::bf16_t; using pg8::bf16x8; using pg8::f32x4; using pg8::u32x4;
typedef unsigned u32x2 __attribute__((ext_vector_type(2)));
#define DI __device__ __forceinline__
#define MFMA16(a, b, c) __builtin_amdgcn_mfma_f32_16x16x32_bf16((a), (b), (c), 0, 0, 0)

constexpr int MT = 16384, DM = 1024, SEQ = 2048;
constexpr int LDS_BYTES = 147456;
constexpr float EPSF = 1e-6f;

constexpr size_t WS_WA = 0;
constexpr size_t WS_WB = WS_WA + 7340032;
constexpr size_t WS_WG = WS_WB + 2097152;
constexpr size_t WS_W1 = WS_WG + 524288;
constexpr size_t WS_W2 = WS_W1 + 8388608;
constexpr size_t WS_HB = WS_W2 + 8388608;
constexpr size_t WS_M  = WS_HB + 33554432;
constexpr size_t WS_RS = WS_M + 33554432;
constexpr size_t WS_ROPE = WS_RS + 65536;
constexpr size_t WS_LB = WS_ROPE + 524288;
constexpr size_t WS_BAR = WS_LB + 32768;
constexpr size_t WS_AGG = WS_LB + 65536;
constexpr size_t WS_BIG = WS_AGG + 4194304;
constexpr size_t WS_PF = WS_BIG + 83886080;
constexpr size_t WS_CARRY = WS_PF + 67108864;
constexpr size_t WS_END = WS_CARRY + 2097152;

struct Prm {
    const float* x; const float* norm_g; const float* rec_w_in; const float* rec_conv_w; const float* rec_conv_b;
    const float* rg_w_r; const float* rg_b_r; const float* rg_w_i; const float* rg_b_i; const float* rg_lambda;
    const float* lb_logits; const float* hgrn_norm_g; const float* rec_w_out; const float* att_w_qkv; const float* att_sinks;
    const float* att_w_o; const float* mlp_w1; const float* mlp_w2;
    float* out; unsigned char* ws;
};

DI int tid_now() { int t = threadIdx.x; asm volatile("" : "+v"(t)); return t; }
DI int bid_now() { int t = blockIdx.x; asm volatile("" : "+s"(t)); return t; }
typedef __bf16 bf16v2_t __attribute__((ext_vector_type(2)));
typedef float f32v2_t __attribute__((ext_vector_type(2)));
DI unsigned pk2(float lo, float hi) { f32v2_t v = {lo, hi}; bf16v2_t r = __builtin_convertvector(v, bf16v2_t); return __builtin_bit_cast(unsigned, r); }
DI bf16_t f2bf(float f) { return (bf16_t)(pk2(f, f) & 0xffffu); }
DI float bf2f(bf16_t b) { return __uint_as_float(((unsigned)b) << 16); }
DI float bflo(unsigned u) { return __uint_as_float(u << 16); }
DI float bfhi(unsigned u) { return __uint_as_float(u & 0xffff0000u); }
DI float sigm(float x) { return __builtin_amdgcn_rcpf(1.0f + __expf(-x)); }
DI float wave_sum(float v) { for (int o = 32; o > 0; o >>= 1) v += __shfl_xor(v, o); return v; }

struct Epi {
    static constexpr bool PERM = true, AFTER_DRAIN = false;
    int mode; bf16_t* O; int ldc; float* Pf; const PG8_LAS float* lbl;
    DI void operator()(const f32x4 (&acc)[2][2][4][2], const pg8::Unit& u, int wr, int wc, int fr, int fq) const {
        const int row0 = u.pm * 256 + wr * 64 + fr, col0 = u.pn * 256 + wc * 32 + 8 * fq;
        const int ctile = u.pn * 256;
        const bool tof32 = (mode == 3) && (ctile >= 1536) && (ctile < 2560);
        const int cshift = (mode == 3) ? (ctile < 1536 ? 0 : (tof32 ? -1536 : -1024)) : 0;
#pragma unroll
        for (int ai = 0; ai < 2; ++ai)
#pragma unroll
            for (int m = 0; m < 4; ++m) {
                const int row = row0 + ai * 128 + m * 16;
#pragma unroll
                for (int bj = 0; bj < 2; ++bj) {
                    f32x4 v0 = acc[ai][bj][m][0], v1 = acc[ai][bj][m][1];
                    const int col = col0 + bj * 128 + cshift;
                    if (tof32) {
                        const f32x4 lb0 = *(const PG8_LAS f32x4*)(lbl + col), lb1 = *(const PG8_LAS f32x4*)(lbl + col + 4);
                        f32x4 o0, o1;
#pragma unroll
                        for (int j = 0; j < 4; ++j) { o0[j] = __logf(lb0[j] + (1.0f - lb0[j]) * sigm(v0[j])); o1[j] = __logf(lb1[j] + (1.0f - lb1[j]) * sigm(v1[j])); }
                        u32x4 w; w.x = pk2(o0[0], o0[1]); w.y = pk2(o0[2], o0[3]); w.z = pk2(o1[0], o1[1]); w.w = pk2(o1[2], o1[3]);
                        *(u32x4*)((unsigned char*)Pf + (size_t)row * 4096 + (col >> 7) * 512 + (col & 127) * 2) = w;
                    } else {
                        if (mode == 2) {
#pragma unroll
                            for (int j = 0; j < 4; ++j) { const float t0 = fmaxf(v0[j], 0.f), t1 = fmaxf(v1[j], 0.f); v0[j] = t0 * t0; v1[j] = t1 * t1; }
                        }
                        u32x4 w; w.x = pk2(v0[0], v0[1]); w.y = pk2(v0[2], v0[3]); w.z = pk2(v1[0], v1[1]); w.w = pk2(v1[2], v1[3]);
                        *(u32x4*)(O + (size_t)row * ldc + col) = w;
                    }
                }
            }
    }
};

DI void conv_wt(const float* __restrict__ src, bf16_t* __restrict__ dst, int K, int N, const float* __restrict__ g, float* tile, int vb, int nvb) {
    const int tid = tid_now();
    const int tn = N / 64, tk = K / 64, nt = tn * tk;
    const int n4 = (tid & 15) * 4, kr = tid >> 4;
    f32x4 nv[2]; float ng[2];
    auto ld = [&](int t) {
        const int k0 = (t / tn) * 64, n0 = (t % tn) * 64;
#pragma unroll
        for (int p = 0; p < 2; ++p) {
            const int k = kr + 32 * p;
            nv[p] = *(const f32x4*)(src + (size_t)(k0 + k) * N + n0 + n4);
            ng[p] = g ? g[k0 + k] : 1.0f;
        }
    };
    if (vb < nt) ld(vb);
    for (int t = vb; t < nt; t += nvb) {
        const int k0 = (t / tn) * 64, n0 = (t % tn) * 64;
#pragma unroll
        for (int p = 0; p < 2; ++p) {
            const int k = kr + 32 * p;
            const f32x4 v = nv[p] * ng[p];
            tile[k * 65 + n4] = v[0]; tile[k * 65 + n4 + 1] = v[1]; tile[k * 65 + n4 + 2] = v[2]; tile[k * 65 + n4 + 3] = v[3];
        }
        if (t + nvb < nt) ld(t + nvb);
        __syncthreads();
        { const int n = tid & 63, kg = tid >> 6;
          u32x4 o;
          o.x = pk2(tile[(kg * 8 + 0) * 65 + n], tile[(kg * 8 + 1) * 65 + n]); o.y = pk2(tile[(kg * 8 + 2) * 65 + n], tile[(kg * 8 + 3) * 65 + n]);
          o.z = pk2(tile[(kg * 8 + 4) * 65 + n], tile[(kg * 8 + 5) * 65 + n]); o.w = pk2(tile[(kg * 8 + 6) * 65 + n], tile[(kg * 8 + 7) * 65 + n]);
          *(u32x4*)(dst + (size_t)(n0 + n) * K + k0 + kg * 8) = o; }
        __syncthreads();
    }
}
DI void conv_gates(const float* __restrict__ w_r, const float* __restrict__ w_i, bf16_t* __restrict__ dst) {
    for (int idx = blockIdx.x * 512 + tid_now(); idx < 4 * 512 * 128; idx += gridDim.x * 512) {
        const int k = idx & 127, np = (idx >> 7) & 511, h = idx >> 16;
        const int w = np >> 6, ct = (np >> 4) & 3, jj = np & 15;
        const int dir = w >> 2, gate = ct >> 1, j = (w & 3) * 32 + (ct & 1) * 16 + jj;
        const float* s = gate ? w_i : w_r;
        dst[idx] = f2bf(s[((dir * 4 + h) * 128 + k) * 128 + j]);
    }
}
DI void conv_layer(const Prm& P, int layer, unsigned char* lds) {
    float* tile = (float*)lds;
    unsigned char* ws = P.ws;
    const float* g = P.norm_g + (size_t)layer * 4096;
    const int vb = blockIdx.x, nvb = gridDim.x;
    if ((layer & 1) == 0) {
        const int r = layer >> 1;
        conv_wt(P.rec_w_in + (size_t)r * 1024 * 3584, (bf16_t*)(ws + WS_WA), 1024, 3584, g, tile, vb, nvb);
        conv_wt(P.rec_w_out + (size_t)r * 1024 * 1024, (bf16_t*)(ws + WS_WB), 1024, 1024, nullptr, tile, vb, nvb);
        conv_gates(P.rg_w_r + (size_t)r * 131072, P.rg_w_i + (size_t)r * 131072, (bf16_t*)(ws + WS_WG));
    } else {
        const int a = layer >> 1;
        conv_wt(P.att_w_qkv + (size_t)a * 1024 * 1536, (bf16_t*)(ws + WS_WA), 1024, 1536, g, tile, vb, nvb);
        conv_wt(P.att_w_o + (size_t)a * 1024 * 1024, (bf16_t*)(ws + WS_WB), 1024, 1024, nullptr, tile, vb, nvb);
    }
}
DI void conv_mlp(const Prm& P, int layer, unsigned char* lds, int vb, int nvb) {
    float* tile = (float*)lds;
    unsigned char* ws = P.ws;
    const float* g = P.norm_g + (size_t)layer * 4096;
    conv_wt(P.mlp_w1 + (size_t)layer * 1024 * 4096, (bf16_t*)(ws + WS_W1), 1024, 4096, g + 2048, tile, vb, nvb);
    conv_wt(P.mlp_w2 + (size_t)layer * 4096 * 1024, (bf16_t*)(ws + WS_W2), 4096, 1024, nullptr, tile, vb, nvb);
}

DI void resnorm_phase(const bf16_t* __restrict__ m, bf16_t* hb, float* rms, const float* __restrict__ gp, float* __restrict__ fout) {
    const int tid_ = tid_now(); const int lane = tid_ & 63, w = tid_ >> 6;
    for (int row = blockIdx.x * 8 + w; row < MT; row += gridDim.x * 8) {
        f32x4 h[4], mv[4]; float ss = 0.f;
        const float r0 = rms[row];
#pragma unroll
        for (int i = 0; i < 4; ++i) {
            const u32x2 q = *(const u32x2*)(m + (size_t)row * 1024 + i * 256 + lane * 4);
            const u32x2 hq = *(const u32x2*)(hb + (size_t)row * 1024 + i * 256 + lane * 4);
            mv[i][0] = bflo(q.x); mv[i][1] = bfhi(q.x); mv[i][2] = bflo(q.y); mv[i][3] = bfhi(q.y);
            h[i][0] = bflo(hq.x) * r0; h[i][1] = bfhi(hq.x) * r0; h[i][2] = bflo(hq.y) * r0; h[i][3] = bfhi(hq.y) * r0;
            ss += mv[i][0] * mv[i][0] + mv[i][1] * mv[i][1] + mv[i][2] * mv[i][2] + mv[i][3] * mv[i][3];
        }
        ss = wave_sum(ss);
        const float rm = rsqrtf(ss * (1.0f / 1024.0f) + EPSF);
        float s2 = 0.f;
#pragma unroll
        for (int i = 0; i < 4; ++i) {
            const f32x4 gv = *(const f32x4*)(gp + i * 256 + lane * 4);
            h[i] = h[i] + mv[i] * rm * gv;
            if (fout) *(f32x4*)(fout + (size_t)row * 1024 + i * 256 + lane * 4) = h[i];
            s2 += h[i][0] * h[i][0] + h[i][1] * h[i][1] + h[i][2] * h[i][2] + h[i][3] * h[i][3];
        }
        if (fout) continue;
        s2 = wave_sum(s2);
        const float s2m = s2 * (1.0f / 1024.0f) + EPSF, rn = rsqrtf(s2m);
#pragma unroll
        for (int i = 0; i < 4; ++i) {
            u32x2 q; q.x = pk2(h[i][0] * rn, h[i][1] * rn); q.y = pk2(h[i][2] * rn, h[i][3] * rn);
            *(u32x2*)(hb + (size_t)row * 1024 + i * 256 + lane * 4) = q;
        }
        if (lane == 0) rms[row] = s2m * rn;
    }
}
DI void input_phase(const float* __restrict__ x, bf16_t* __restrict__ hb, float* __restrict__ rms) {
    const int tid_ = tid_now(); const int lane = tid_ & 63, w = tid_ >> 6;
    for (int row = blockIdx.x * 8 + w; row < MT; row += gridDim.x * 8) {
        f32x4 h[4]; float s2 = 0.f;
#pragma unroll
        for (int i = 0; i < 4; ++i) {
            h[i] = *(const f32x4*)(x + (size_t)row * 1024 + i * 256 + lane * 4);
            s2 += h[i][0] * h[i][0] + h[i][1] * h[i][1] + h[i][2] * h[i][2] + h[i][3] * h[i][3];
        }
        s2 = wave_sum(s2);
        const float s2m = s2 * (1.0f / 1024.0f) + EPSF, rn = rsqrtf(s2m);
#pragma unroll
        for (int i = 0; i < 4; ++i) {
            u32x2 q; q.x = pk2(h[i][0] * rn, h[i][1] * rn); q.y = pk2(h[i][2] * rn, h[i][3] * rn);
            *(u32x2*)(hb + (size_t)row * 1024 + i * 256 + lane * 4) = q;
        }
        if (lane == 0) rms[row] = s2m * rn;
    }
}

DI void prep_phase(const Prm& P, unsigned char* lds) {
    unsigned char* ws = P.ws;
    float* lbv = (float*)(ws + WS_LB);
    float* rc = (float*)(ws + WS_ROPE); float* rsn = rc + 2048 * 32;
    const int gt = blockIdx.x * 512 + tid_now(), gn = gridDim.x * 512;
    for (int i = gt; i < 1024; i += gn) {
        const int d = i >> 9, c = i & 511;
        const float l0 = P.lb_logits[(d * 2 + 0) * 512 + c], l1 = P.lb_logits[(d * 2 + 1) * 512 + c];
        const float mx = fmaxf(l0, l1), e0 = expf(l0 - mx), e1 = expf(l1 - mx);
        lbv[(0 * 2 + d) * 512 + c] = 0.f;
        lbv[(1 * 2 + d) * 512 + c] = e1 / (e0 + e1);
    }
    { float* rgc = (float*)(ws + WS_LB + 8192);
      for (int i = gt; i < 2048; i += gn) {
          rgc[i * 3 + 0] = P.rg_b_r[i]; rgc[i * 3 + 1] = P.rg_b_i[i];
          rgc[i * 3 + 2] = -8.0f * log1pf(expf(-P.rg_lambda[i]));
      } }
    for (int i = gt; i < 2048 * 32; i += gn) {
        const int pos = i >> 5, f = i & 31;
        const float inv = powf(10000.0f, -(float)(2 * f) / 64.0f);
        const float ang = (float)pos * inv;
        rc[i] = cosf(ang); rsn[i] = sinf(ang);
    }
    conv_layer(P, 0, lds);
    input_phase(P.x, (bf16_t*)(ws + WS_HB), (float*)(ws + WS_RS));
}

DI void hgrn_pre(const Prm& P, int it, unsigned char* lds) {
    const int tid = tid_now(), lane = tid & 63, w = tid >> 6, r16 = lane & 15, quad = lane >> 4;
    const int na = it & 63, h = (it >> 6) & 3, b = it >> 8;
    bf16_t* qeL = (bf16_t*)lds;
    bf16_t* keL = qeL + 2 * 32 * 136;
    bf16_t* vT = keL + 2 * 32 * 136;
    float* gtot = (float*)(vT + 128 * 40);
    bf16_t* attL = (bf16_t*)(gtot + 1024);
    unsigned char* PfB = P.ws + WS_PF; unsigned char* PbB = P.ws + WS_BIG;
    bf16_t* Ob = (bf16_t*)(P.ws + WS_M);
    const int ch = tid & 127, tg = tid >> 7;
    const size_t row0 = (size_t)b * SEQ + na * 32;
    float lf0[8], lf1[8], q[8], v[8], c0[8], c1[8];
#pragma unroll
    for (int j = 0; j < 8; ++j) {
        const size_t row = row0 + tg * 8 + j;
        lf0[j] = bf2f(*(const bf16_t*)(PfB + row * 4096 + h * 512 + ch * 2));
        lf1[j] = bf2f(*(const bf16_t*)(PfB + row * 4096 + 2048 + h * 512 + ch * 2));
        q[j] = bf2f(*(const bf16_t*)(PbB + row * 5120 + (1024 + h * 128 + ch) * 2));
        v[j] = bf2f(*(const bf16_t*)(PbB + row * 5120 + (1536 + h * 128 + ch) * 2));
    }
    { float run = 0.f;
#pragma unroll
      for (int j = 0; j < 8; ++j) { run += lf0[j]; c0[j] = run; }
      run = 0.f;
#pragma unroll
      for (int j = 7; j >= 0; --j) { run += lf1[j]; c1[j] = run; } }
    gtot[tg * 128 + ch] = c0[7]; gtot[512 + tg * 128 + ch] = c1[0];
    asm volatile("s_waitcnt vmcnt(0)" ::: "memory");
    __syncthreads();
    float pre0 = 0.f, bt0 = 0.f, pre1 = 0.f, bt1 = 0.f;
#pragma unroll
    for (int g = 0; g < 4; ++g) {
        const float x0 = gtot[g * 128 + ch], x1 = gtot[512 + g * 128 + ch];
        bt0 += x0; bt1 += x1; if (g < tg) pre0 += x0; if (g > tg) pre1 += x1;
    }
    {
        float kd0[8], kd1[8];
#pragma unroll
        for (int j = 0; j < 8; ++j) {
            const int i = tg * 8 + j;
            const float bc0 = pre0 + c0[j], bc1 = pre1 + c1[j];
            const float k0 = 1.0f - __expf(lf0[j]), k1 = 1.0f - __expf(lf1[j]);
            const bf16_t qe0 = f2bf(q[j] * __expf(bc0)), qe1 = f2bf(q[j] * __expf(bc1));
            qeL[i * 136 + ch] = qe0; qeL[(32 + i) * 136 + ch] = qe1;
            keL[i * 136 + ch] = f2bf(k0 * __expf(-bc0)); keL[(32 + i) * 136 + ch] = f2bf(k1 * __expf(-bc1));
            kd0[j] = k0 * __expf(bt0 - bc0); kd1[j] = k1 * __expf(bt1 - bc1);
            *(bf16_t*)(PfB + (row0 + i) * 4096 + h * 512 + ch * 2) = qe0;
            *(bf16_t*)(PfB + (row0 + i) * 4096 + 2048 + h * 512 + ch * 2) = qe1;
        }
        u32x4 p0, p1, vp;
        p0.x = pk2(kd0[0], kd0[1]); p0.y = pk2(kd0[2], kd0[3]); p0.z = pk2(kd0[4], kd0[5]); p0.w = pk2(kd0[6], kd0[7]);
        p1.x = pk2(kd1[0], kd1[1]); p1.y = pk2(kd1[2], kd1[3]); p1.z = pk2(kd1[4], kd1[5]); p1.w = pk2(kd1[6], kd1[7]);
        vp.x = pk2(v[0], v[1]); vp.y = pk2(v[2], v[3]); vp.z = pk2(v[4], v[5]); vp.w = pk2(v[6], v[7]);
        const size_t srow = row0 + (ch >> 2);
        *(u32x4*)(PfB + srow * 4096 + h * 512 + 256 + (ch & 3) * 64 + tg * 16) = p0;
        *(u32x4*)(PfB + srow * 4096 + 2048 + h * 512 + 256 + (ch & 3) * 64 + tg * 16) = p1;
        *(u32x4*)(PbB + srow * 5120 + (1536 + h * 128) * 2 + (ch & 3) * 64 + tg * 16) = vp;
        *(u32x4*)(vT + ch * 40 + tg * 8) = vp;
        if (tg < 2) {
            const float dv = __expf(tg ? bt1 : bt0);
            *(float*)(PbB + (row0 + tg * 2 + (ch >> 6)) * 5120 + (1024 + h * 128) * 2 + (ch & 63) * 4) = dv;
        }
    }
    __syncthreads();
    {
        const int d = w >> 2, rt = (w >> 1) & 1, ct = w & 1;
        f32x4 acc = (f32x4){0.f, 0.f, 0.f, 0.f};
#pragma unroll
        for (int ks = 0; ks < 4; ++ks) {
            const bf16x8 a = *(const bf16x8*)(qeL + (d * 32 + rt * 16 + r16) * 136 + ks * 32 + quad * 8);
            const bf16x8 bb = *(const bf16x8*)(keL + (d * 32 + ct * 16 + r16) * 136 + ks * 32 + quad * 8);
            acc = MFMA16(a, bb, acc);
        }
#pragma unroll
        for (int reg = 0; reg < 4; ++reg) {
            const int cc = rt * 16 + quad * 4 + reg, ee = ct * 16 + r16;
            const bool keep = d ? (ee >= cc) : (ee <= cc);
            attL[(d * 32 + cc) * 40 + ee] = f2bf(keep ? acc[reg] : 0.f);
        }
    }
    __syncthreads();
    {
        const int d = w >> 2;
        bf16_t* Od = Ob + (size_t)d * MT * 512;
#pragma unroll
        for (int q4 = 0; q4 < 4; ++q4) {
            const int ti = (w & 3) * 4 + q4, rt = ti >> 3, dvt = ti & 7;
            const bf16x8 a = *(const bf16x8*)(attL + (d * 32 + rt * 16 + r16) * 40 + quad * 8);
            const bf16x8 bb = *(const bf16x8*)(vT + (dvt * 16 + r16) * 40 + quad * 8);
            const f32x4 o = MFMA16(bb, a, ((f32x4){0.f, 0.f, 0.f, 0.f}));
            u32x2 ow; ow.x = pk2(o[0], o[1]); ow.y = pk2(o[2], o[3]);
            *(u32x2*)(Od + (row0 + rt * 16 + r16) * 512 + h * 128 + dvt * 16 + quad * 4) = ow;
        }
    }
    __syncthreads();
}

struct HgShared { u32x4 rq, rk; float rd; };
struct HgPriv { u32x4 rv; u32x2 oin[2]; };
DI void hgrn_seq(const Prm& P, int it, unsigned char* lds) {
    const int tid = tid_now(), lane = tid & 63, w = tid >> 6, r16 = lane & 15, quad = lane >> 4;
    const int dir = it & 1, h = (it >> 1) & 3, b = it >> 3;
    bf16_t* STw = (bf16_t*)(lds + 38912) + w * (16 * 136);
    const unsigned char* PfB = P.ws + WS_PF; const unsigned char* PbB = P.ws + WS_BIG;
    bf16_t* Od = (bf16_t*)(P.ws + WS_M) + (size_t)dir * MT * 512;
    const int qrow = tid >> 4, qpc = tid & 15, kdk = tid >> 2, kpc = tid & 3, dvl = 16 * w + r16;
    for (int i = lane; i < 16 * 136; i += 64) STw[i] = 0;
    f32x4 Sacc[8];
#pragma unroll
    for (int i = 0; i < 8; ++i) Sacc[i] = (f32x4){0.f, 0.f, 0.f, 0.f};
    auto load_sh = [&](int n, HgShared& s) {
        const size_t row0 = (size_t)b * SEQ + (dir ? 63 - n : n) * 32;
        s.rq = *(const u32x4*)(PfB + (row0 + qrow) * 4096 + dir * 2048 + h * 512 + qpc * 16);
        s.rk = *(const u32x4*)(PfB + (row0 + (kdk >> 2)) * 4096 + dir * 2048 + h * 512 + 256 + (kdk & 3) * 64 + kpc * 16);
        s.rd = (tid < 128) ? *(const float*)(PbB + (row0 + dir * 2 + (tid >> 6)) * 5120 + (1024 + h * 128) * 2 + (tid & 63) * 4) : 0.f;
    };
    auto load_pr = [&](int n, HgPriv& p) {
        const size_t row0 = (size_t)b * SEQ + (dir ? 63 - n : n) * 32;
        p.rv = *(const u32x4*)(PbB + (row0 + (dvl >> 2)) * 5120 + (1536 + h * 128) * 2 + (dvl & 3) * 64 + quad * 16);
#pragma unroll
        for (int rt = 0; rt < 2; ++rt) p.oin[rt] = *(const u32x2*)(Od + (row0 + rt * 16 + r16) * 512 + h * 128 + 16 * w + quad * 4);
    };
    auto store_sh = [&](int st, const HgShared& s) {
        unsigned char* base = lds + st * 19456;
        *(u32x4*)(base + (qrow * 136 + qpc * 8) * 2) = s.rq;
        *(u32x4*)(base + 8704 + (kdk * 40 + kpc * 8) * 2) = s.rk;
        if (tid < 128) *(float*)(base + 18944 + tid * 4) = s.rd;
    };
    HgShared X, Y; HgPriv cur, PX, PY;
    load_sh(0, X); load_pr(0, cur); store_sh(0, X);
    load_sh(1, X); load_pr(1, PX);
    Y = X; PY = PX;
    __syncthreads();
    for (int n = 0; n < 64; ++n) {
        if (n + 2 < 64) { load_sh(n + 2, Y); load_pr(n + 2, PY); }
        const unsigned char* base = lds + (n & 1) * 19456;
        const bf16_t* QE = (const bf16_t*)base; const bf16_t* KT = (const bf16_t*)(base + 8704); const float* DEC = (const float*)(base + 18944);
        const size_t row0 = (size_t)b * SEQ + (dir ? 63 - n : n) * 32;
        bf16x8 sb[4];
#pragma unroll
        for (int ks = 0; ks < 4; ++ks) sb[ks] = *(const bf16x8*)(STw + r16 * 136 + ks * 32 + quad * 8);
#pragma unroll
        for (int rt = 0; rt < 2; ++rt) {
            f32x4 o = (f32x4){0.f, 0.f, 0.f, 0.f};
#pragma unroll
            for (int ks = 0; ks < 4; ++ks) {
                const bf16x8 qa = *(const bf16x8*)(QE + (rt * 16 + r16) * 136 + ks * 32 + quad * 8);
                o = MFMA16(sb[ks], qa, o);
            }
            const u32x2 oi = cur.oin[rt];
            u32x2 ow; ow.x = pk2(o[0] + bflo(oi.x), o[1] + bfhi(oi.x)); ow.y = pk2(o[2] + bflo(oi.y), o[3] + bfhi(oi.y));
            *(u32x2*)(Od + (row0 + rt * 16 + r16) * 512 + h * 128 + 16 * w + quad * 4) = ow;
        }
        const bf16x8 vb = __builtin_bit_cast(bf16x8, cur.rv);
#pragma unroll
        for (int dkt = 0; dkt < 8; ++dkt) {
            const f32x4 dv4 = *(const f32x4*)(DEC + dkt * 16 + quad * 4);
            const bf16x8 ka = *(const bf16x8*)(KT + (dkt * 16 + r16) * 40 + quad * 8);
            Sacc[dkt] = MFMA16(ka, vb, Sacc[dkt] * dv4);
            u32x2 sp; sp.x = pk2(Sacc[dkt][0], Sacc[dkt][1]); sp.y = pk2(Sacc[dkt][2], Sacc[dkt][3]);
            *(u32x2*)(STw + r16 * 136 + dkt * 16 + quad * 4) = sp;
        }
        if (n + 1 < 64) store_sh((n + 1) & 1, X);
        __syncthreads();
        X = Y; cur = PX; PX = PY;
    }
}

DI void hgrn_finish(const Prm& P, int r) {
    const int tid_ = tid_now(); const int lane = tid_ & 63, w = tid_ >> 6;
    const bf16_t* O0 = (const bf16_t*)(P.ws + WS_M); const bf16_t* O1 = O0 + (size_t)MT * 512;
    const bf16_t* Pb = (const bf16_t*)(P.ws + WS_BIG);
    bf16_t* Y = (bf16_t*)P.out;
    const float* ng = P.hgrn_norm_g + r * 512;
    const int c0 = lane * 8;
    for (int row = blockIdx.x * 8 + w; row < MT; row += gridDim.x * 8) {
        const u32x4 a = *(const u32x4*)(O0 + (size_t)row * 512 + c0), bq = *(const u32x4*)(O1 + (size_t)row * 512 + c0);
        const u32x4 gq = *(const u32x4*)(Pb + (size_t)row * 2560 + 2048 + c0);
        float o[8], g[8];
#pragma unroll
        for (int j = 0; j < 4; ++j) {
            o[2 * j] = bflo(a[j]) + bflo(bq[j]); o[2 * j + 1] = bfhi(a[j]) + bfhi(bq[j]);
            g[2 * j] = bflo(gq[j]); g[2 * j + 1] = bfhi(gq[j]);
        }
        float ss = 0.f;
#pragma unroll
        for (int j = 0; j < 8; ++j) ss += o[j] * o[j];
        ss += __shfl_xor(ss, 1); ss += __shfl_xor(ss, 2); ss += __shfl_xor(ss, 4); ss += __shfl_xor(ss, 8);
        const float rn = rsqrtf(ss * (1.0f / 128.0f) + EPSF);
        float y[8];
#pragma unroll
        for (int j = 0; j < 8; ++j) y[j] = o[j] * rn * ng[c0 + j] * (g[j] * sigm(g[j]));
        u32x4 q; q.x = pk2(y[0], y[1]); q.y = pk2(y[2], y[3]); q.z = pk2(y[4], y[5]); q.w = pk2(y[6], y[7]);
        *(u32x4*)(Y + (size_t)row * 1024 + 512 + c0) = q;
    }
}

DI float rcpf_(float x) { return __builtin_amdgcn_rcpf(x); }
DI float sigm_fast(float x) { return rcpf_(1.0f + __expf(-x)); }
template <int PASS>
DI void rg_loop(const Prm& P, int r, int h, int idx0, int stride, unsigned char* lds) {
    const int tid = tid_now(), lane = tid & 63, w = tid >> 6, r16 = lane & 15, quad = lane >> 4;
    constexpr int RS = 132;
    float* xcf = (float*)lds;
    bf16_t* xcb = (bf16_t*)(lds + 33792);
    bf16_t* Aa = (bf16_t*)(lds + 51200);
    bf16_t* Uu = (bf16_t*)(lds + 86016);
    float* carr = (float*)(lds + 120832);
    const bf16_t* Pb = (const bf16_t*)(P.ws + WS_BIG);
    unsigned long long* agg = (unsigned long long*)(P.ws + WS_AGG);
    const float* rgc = (const float*)(P.ws + WS_LB + 8192);
    bf16_t* Y = (bf16_t*)P.out;
    const int ch = tid & 127, tg = tid >> 7;
    const int tgu = __builtin_amdgcn_readfirstlane(w) >> 1;
    const bf16_t* Wg = (const bf16_t*)(P.ws + WS_WG) + (size_t)h * 512 * 128;
    bf16x8 wb[4][4];
#pragma unroll
    for (int ks = 0; ks < 4; ++ks)
#pragma unroll
        for (int ct = 0; ct < 4; ++ct) wb[ks][ct] = *(const bf16x8*)(Wg + (size_t)(w * 64 + ct * 16 + r16) * 128 + ks * 32 + quad * 8);
    float ecn[2][3];
    {
        const int dir = w >> 2;
#pragma unroll
        for (int ctl = 0; ctl < 2; ++ctl) {
            const int c = h * 128 + (w & 3) * 32 + ctl * 16 + r16;
#pragma unroll
            for (int q = 0; q < 3; ++q) ecn[ctl][q] = rgc[((r * 2 + dir) * 512 + c) * 3 + q];
        }
    }
    float cw[4];
#pragma unroll
    for (int k = 0; k < 4; ++k) cw[k] = P.rec_conv_w[(r * 4 + k) * 512 + h * 128 + ch];
    const float cb = P.rec_conv_b[r * 512 + h * 128 + ch];
    float xnx[19];
    auto load_xin = [&](int idx) {
        const int cn = idx & 31, b = idx >> 5;
#pragma unroll
        for (int j = 0; j < 19; ++j) {
            const int tt = cn * 64 + tgu * 16 + j - 2;
            const int tc = tt < 0 ? 0 : (tt >= SEQ ? SEQ - 1 : tt);
            const float v = bf2f(Pb[((size_t)b * SEQ + tc) * 2560 + h * 128 + ch]);
            xnx[j] = (tt >= 0 && tt < SEQ) ? v : 0.f;
        }
    };
    if (idx0 < 256) load_xin(idx0);
    for (int it = idx0; it < 256; it += stride) {
        const int cn = it & 31, b = it >> 5;
        const size_t abase = (size_t)((b * 4 + h) * 32);
        float gav[16];
        unsigned long long fe[16];
        const int wu = __builtin_amdgcn_readfirstlane(w);
        const int fdir = (wu >> 1) & 1, fhalf = wu >> 2, fc = tid & 127;
        const int fm = fdir ? 31 - cn : cn, fm0 = fm >> 1;
        const int fcnt = fhalf ? fm - fm0 : fm0, ffirst = fhalf ? fm0 : 0;
        if (PASS == 2) {
#pragma unroll
            for (int i = 0; i < 16; ++i) {
                const int ii = (i < fcnt) ? (ffirst + i) : 0;
                const int k = fdir ? 31 - ii : ii;
                fe[i] = agg[((abase + k) * 2 + fdir) * 128 + fc];
            }
        }
#pragma unroll
        for (int j = 0; j < 16; ++j) {
            const int i = tg * 16 + j;
            const float a = cb + cw[0] * xnx[j] + cw[1] * xnx[j + 1] + cw[2] * xnx[j + 2] + cw[3] * xnx[j + 3];
            xcf[i * RS + ch] = a; xcb[i * 136 + ch] = f2bf(a);
        }
        { const int itn = it + stride; load_xin(itn < 256 ? itn : it); }
        __syncthreads();
        if (PASS == 2) {
            float pp = 1.f, hh = 0.f;
#pragma unroll
            for (int i = 0; i < 16; ++i) {
                const float ex = (i < fcnt) ? __uint_as_float((unsigned)fe[i]) : 1.0f, ey = (i < fcnt) ? __uint_as_float((unsigned)(fe[i] >> 32)) : 0.0f;
                hh = ex * hh + ey; pp *= ex;
            }
            carr[(fhalf * 256 + (tid & 255)) * 2] = pp; carr[(fhalf * 256 + (tid & 255)) * 2 + 1] = hh;
        }
#pragma unroll 1
        for (int hf = 0; hf < 2; ++hf) {
            const int r0 = hf * 32;
            f32x4 acc[2][4];
#pragma unroll
            for (int rt = 0; rt < 2; ++rt)
#pragma unroll
                for (int ct = 0; ct < 4; ++ct) acc[rt][ct] = (f32x4){0.f, 0.f, 0.f, 0.f};
#pragma unroll
            for (int ks = 0; ks < 4; ++ks) {
                bf16x8 xa[2];
#pragma unroll
                for (int rt = 0; rt < 2; ++rt) xa[rt] = *(const bf16x8*)(xcb + (r0 + rt * 16 + r16) * 136 + ks * 32 + quad * 8);
#pragma unroll
                for (int ct = 0; ct < 4; ++ct)
#pragma unroll
                    for (int rt = 0; rt < 2; ++rt) acc[rt][ct] = MFMA16(xa[rt], wb[ks][ct], acc[rt][ct]);
            }
            const int dir = w >> 2;
#pragma unroll
            for (int ctl = 0; ctl < 2; ++ctl) {
                const int j = (w & 3) * 32 + ctl * 16 + r16;
                const float br = ecn[ctl][0], bi = ecn[ctl][1], sp8 = ecn[ctl][2];
#pragma unroll
                for (int rt = 0; rt < 2; ++rt)
#pragma unroll
                    for (int reg = 0; reg < 4; ++reg) {
                        const int i = r0 + rt * 16 + quad * 4 + reg;
                        const float er = 1.0f + __expf(fminf(-(acc[rt][ctl][reg] + br), 40.0f)), ei = 1.0f + __expf(fminf(-(acc[rt][ctl + 2][reg] + bi), 40.0f));
                        const float rc2 = rcpf_(er * ei);
                        const float rr = rc2 * ei, ii = rc2 * er;
                        const float a = __expf(rr * sp8);
                        const float u = __builtin_amdgcn_sqrtf(fmaxf(1.0f - a * a, 0.f)) * ii * xcf[i * RS + j];
                        Aa[(dir * 64 + i) * 136 + j] = f2bf(1.0f - a); Uu[(dir * 64 + i) * 136 + j] = f2bf(u);
                    }
            }
        }
        __syncthreads();
        if (PASS == 2) {
#pragma unroll
            for (int j = 0; j < 16; ++j) gav[j] = bf2f(Pb[((size_t)b * SEQ + cn * 64 + tgu * 16 + j) * 2560 + 512 + h * 128 + ch]);
        }
        if (tid < 256) {
            const int dir = tid >> 7, c = tid & 127;
            if (PASS == 1) {
                float pp = 1.f, hh = 0.f;
#pragma unroll 8
                for (int s = 0; s < 64; ++s) {
                    const int i = dir ? 63 - s : s;
                    const float a = 1.0f - bf2f(Aa[(dir * 64 + i) * 136 + c]), u = bf2f(Uu[(dir * 64 + i) * 136 + c]);
                    hh = a * hh + u; pp *= a;
                }
                agg[((abase + cn) * 2 + dir) * 128 + c] = ((unsigned long long)__float_as_uint(hh) << 32) | __float_as_uint(pp);
            } else {
                float hc = carr[(256 + tid) * 2] * carr[tid * 2 + 1] + carr[(256 + tid) * 2 + 1];
#pragma unroll 8
                for (int s = 0; s < 64; ++s) {
                    const int i = dir ? 63 - s : s;
                    const float a = 1.0f - bf2f(Aa[(dir * 64 + i) * 136 + c]), u = bf2f(Uu[(dir * 64 + i) * 136 + c]);
                    hc = a * hc + u; Uu[(dir * 64 + i) * 136 + c] = f2bf(hc);
                }
            }
        }
        if (PASS == 2) {
            __syncthreads();
#pragma unroll
            for (int j = 0; j < 16; ++j) {
                const int i = tgu * 16 + j, t = cn * 64 + i; const size_t row = (size_t)b * SEQ + t;
                const float ga = gav[j];
                const float inner = 0.7978845608028654f * (ga + 0.044715f * ga * ga * ga);
                const float th = 1.0f - 2.0f * rcpf_(__expf(2.0f * inner) + 1.0f);
                const float gl = 0.5f * ga * (1.0f + th);
                Y[row * 1024 + h * 128 + ch] = f2bf(gl * (bf2f(Uu[i * 136 + ch]) + bf2f(Uu[(64 + i) * 136 + ch])));
            }
        }
        __syncthreads();
    }
}

template <int CTRL> DI float dppf(float v) { return __builtin_bit_cast(float, __builtin_amdgcn_update_dpp(0, __builtin_bit_cast(int, v), CTRL, 0xf, 0xf, false)); }
DI float row16_max(float v) { v = fmaxf(v, dppf<0xB1>(v)); v = fmaxf(v, dppf<0x4E>(v)); v = fmaxf(v, dppf<0x124>(v)); v = fmaxf(v, dppf<0x128>(v)); return v; }
DI float row16_sum(float v) { v += dppf<0xB1>(v); v += dppf<0x4E>(v); v += dppf<0x124>(v); v += dppf<0x128>(v); return v; }
DI void att_item(const Prm& P, int al, int it, unsigned char* lds) {
    constexpr float QSC = 0.125f * 1.4426950408889634f;
    const int tid = tid_now(), lane = tid & 63, w = tid >> 6, r16 = lane & 15, quad = lane >> 4;
    const int gh = it & 1, n = (it >> 1) & 15, kvh = (it >> 5) & 3, b = it >> 7;
    bf16_t* Ks = (bf16_t*)lds;
    bf16_t* VT = (bf16_t*)(lds + 55296);
    bf16_t* Pw = (bf16_t*)(lds + 105472) + w * (32 * 72);
    const bf16_t* QKV = (const bf16_t*)(P.ws + WS_BIG);
    const float* rc = (const float*)(P.ws + WS_ROPE); const float* rsn = rc + 2048 * 32;
    bf16_t* Oo = (bf16_t*)P.out;
    const int k_lo = (n * 128 - 128) < 0 ? 0 : (n * 128 - 128);
    const int k_hi = (n * 128 + 256) > SEQ ? SEQ : (n * 128 + 256);
    const int nk = k_hi - k_lo;
    for (int task = tid; task < nk * 4; task += 512) {
        const int key = task >> 2, dg = task & 3, pos = k_lo + key;
        const bf16_t* src = QKV + ((size_t)b * SEQ + pos) * 1536 + 1024 + kvh * 64 + dg * 8;
        const u32x4 lo = *(const u32x4*)src, hi = *(const u32x4*)(src + 32);
        const f32x4 c0 = *(const f32x4*)(rc + pos * 32 + dg * 8), c1 = *(const f32x4*)(rc + pos * 32 + dg * 8 + 4);
        const f32x4 s0 = *(const f32x4*)(rsn + pos * 32 + dg * 8), s1 = *(const f32x4*)(rsn + pos * 32 + dg * 8 + 4);
        float x1[8], x2[8], o1[8], o2[8];
#pragma unroll
        for (int j = 0; j < 4; ++j) { x1[2 * j] = bflo(lo[j]); x1[2 * j + 1] = bfhi(lo[j]); x2[2 * j] = bflo(hi[j]); x2[2 * j + 1] = bfhi(hi[j]); }
#pragma unroll
        for (int j = 0; j < 8; ++j) {
            const float cs = j < 4 ? c0[j & 3] : c1[j & 3], sn = j < 4 ? s0[j & 3] : s1[j & 3];
            o1[j] = x1[j] * cs - x2[j] * sn; o2[j] = x2[j] * cs + x1[j] * sn;
        }
        u32x4 w1, w2;
        w1.x = pk2(o1[0], o1[1]); w1.y = pk2(o1[2], o1[3]); w1.z = pk2(o1[4], o1[5]); w1.w = pk2(o1[6], o1[7]);
        w2.x = pk2(o2[0], o2[1]); w2.y = pk2(o2[2], o2[3]); w2.z = pk2(o2[4], o2[5]); w2.w = pk2(o2[6], o2[7]);
        *(u32x4*)(Ks + key * 72 + dg * 8) = w1;
        *(u32x4*)(Ks + key * 72 + 32 + dg * 8) = w2;
    }
    for (int task = tid; task < nk * 4; task += 512) {
        const int kp = task >> 3, dg = task & 7, pos = k_lo + 2 * kp;
        const bf16_t* src = QKV + ((size_t)b * SEQ + pos) * 1536 + 1280 + kvh * 64 + dg * 8;
        const u32x4 va = *(const u32x4*)src, vb2 = *(const u32x4*)(src + 1536);
#pragma unroll
        for (int j = 0; j < 4; ++j) {
            *(unsigned*)(VT + (dg * 8 + 2 * j) * 392 + 2 * kp) = (va[j] & 0xffffu) | (vb2[j] << 16);
            *(unsigned*)(VT + (dg * 8 + 2 * j + 1) * 392 + 2 * kp) = (va[j] >> 16) | (vb2[j] & 0xffff0000u);
        }
    }
    const int hq = kvh * 4 + gh * 2 + (w >> 2), qrow0 = n * 128 + (w & 3) * 32;
    bf16x8 qa[2][2];
#pragma unroll
    for (int rt = 0; rt < 2; ++rt) {
        const int pos = qrow0 + rt * 16 + r16;
        const bf16_t* src = QKV + ((size_t)b * SEQ + pos) * 1536 + hq * 64 + quad * 8;
        const u32x4 lo = *(const u32x4*)src, hi = *(const u32x4*)(src + 32);
        const f32x4 c0 = *(const f32x4*)(rc + pos * 32 + quad * 8), c1 = *(const f32x4*)(rc + pos * 32 + quad * 8 + 4);
        const f32x4 s0 = *(const f32x4*)(rsn + pos * 32 + quad * 8), s1 = *(const f32x4*)(rsn + pos * 32 + quad * 8 + 4);
        float x1[8], x2[8], o1[8], o2[8];
#pragma unroll
        for (int j = 0; j < 4; ++j) { x1[2 * j] = bflo(lo[j]); x1[2 * j + 1] = bfhi(lo[j]); x2[2 * j] = bflo(hi[j]); x2[2 * j + 1] = bfhi(hi[j]); }
#pragma unroll
        for (int j = 0; j < 8; ++j) {
            const float cs = j < 4 ? c0[j & 3] : c1[j & 3], sn = j < 4 ? s0[j & 3] : s1[j & 3];
            o1[j] = (x1[j] * cs - x2[j] * sn) * QSC; o2[j] = (x2[j] * cs + x1[j] * sn) * QSC;
        }
        u32x4 w1, w2;
        w1.x = pk2(o1[0], o1[1]); w1.y = pk2(o1[2], o1[3]); w1.z = pk2(o1[4], o1[5]); w1.w = pk2(o1[6], o1[7]);
        w2.x = pk2(o2[0], o2[1]); w2.y = pk2(o2[2], o2[3]); w2.z = pk2(o2[4], o2[5]); w2.w = pk2(o2[6], o2[7]);
        qa[rt][0] = __builtin_bit_cast(bf16x8, w1); qa[rt][1] = __builtin_bit_cast(bf16x8, w2);
    }
    const float sink = P.att_sinks[al * 16 + hq] * 1.4426950408889634f;
    float mq[2], lq[2];
    f32x4 o[4][2];
#pragma unroll
    for (int qt = 0; qt < 2; ++qt) {
        mq[qt] = sink; lq[qt] = (quad == 0) ? 1.0f : 0.0f;
#pragma unroll
        for (int dt = 0; dt < 4; ++dt) o[dt][qt] = (f32x4){0.f, 0.f, 0.f, 0.f};
    }
    __syncthreads();
    const int nkc = nk >> 6;
    for (int kc = 0; kc < nkc; ++kc) {
        const int kmin = k_lo + kc * 64;
        if (kmin + 63 < qrow0 - 128 || kmin > qrow0 + 31 + 128) continue;
        const bool interior = (kmin >= qrow0 + 31 - 128) && (kmin + 63 <= qrow0 + 128);
        f32x4 s[4][2];
#pragma unroll
        for (int kt = 0; kt < 4; ++kt)
#pragma unroll
            for (int qt = 0; qt < 2; ++qt) s[kt][qt] = (f32x4){0.f, 0.f, 0.f, 0.f};
        __builtin_amdgcn_s_setprio(1);
#pragma unroll
        for (int ks = 0; ks < 2; ++ks)
#pragma unroll
            for (int kt = 0; kt < 4; ++kt) {
                const bf16x8 ka = *(const bf16x8*)(Ks + (kc * 64 + kt * 16 + r16) * 72 + ks * 32 + quad * 8);
#pragma unroll
                for (int qt = 0; qt < 2; ++qt) s[kt][qt] = MFMA16(ka, qa[qt][ks], s[kt][qt]);
            }
        __builtin_amdgcn_s_setprio(0);
#pragma unroll
        for (int qt = 0; qt < 2; ++qt) {
            const int qpos = qrow0 + qt * 16 + r16;
            float mx = -1e30f;
            if (interior) {
#pragma unroll
                for (int kt = 0; kt < 4; ++kt)
#pragma unroll
                    for (int reg = 0; reg < 4; ++reg) mx = fmaxf(mx, s[kt][qt][reg]);
            } else {
#pragma unroll
                for (int kt = 0; kt < 4; ++kt)
#pragma unroll
                    for (int reg = 0; reg < 4; ++reg) {
                        const int d = qpos - (kmin + kt * 16 + quad * 4 + reg);
                        const float sv = (d <= 128 && d >= -128) ? s[kt][qt][reg] : -1e30f;
                        s[kt][qt][reg] = sv; mx = fmaxf(mx, sv);
                    }
            }
            mx = fmaxf(mx, __shfl_xor(mx, 16)); mx = fmaxf(mx, __shfl_xor(mx, 32));
            const float mn = fmaxf(mq[qt], mx), alpha = __builtin_amdgcn_exp2f(mq[qt] - mn);
            mq[qt] = mn;
            float ps = 0.f;
#pragma unroll
            for (int kt = 0; kt < 4; ++kt) {
                const float p0 = __builtin_amdgcn_exp2f(s[kt][qt][0] - mn), p1 = __builtin_amdgcn_exp2f(s[kt][qt][1] - mn);
                const float p2 = __builtin_amdgcn_exp2f(s[kt][qt][2] - mn), p3 = __builtin_amdgcn_exp2f(s[kt][qt][3] - mn);
                ps += (p0 + p1) + (p2 + p3);
                u32x2 pw; pw.x = pk2(p0, p1); pw.y = pk2(p2, p3);
                *(u32x2*)(Pw + (qt * 16 + r16) * 72 + kt * 16 + quad * 4) = pw;
            }
            lq[qt] = lq[qt] * alpha + ps;
#pragma unroll
            for (int dt = 0; dt < 4; ++dt) o[dt][qt] = o[dt][qt] * alpha;
        }
        asm volatile("s_waitcnt lgkmcnt(0)" ::: "memory");
        __builtin_amdgcn_s_setprio(1);
#pragma unroll
        for (int ks = 0; ks < 2; ++ks) {
            bf16x8 pb[2];
#pragma unroll
            for (int qt = 0; qt < 2; ++qt) pb[qt] = *(const bf16x8*)(Pw + (qt * 16 + r16) * 72 + ks * 32 + quad * 8);
#pragma unroll
            for (int dt = 0; dt < 4; ++dt) {
                const bf16x8 va = *(const bf16x8*)(VT + (dt * 16 + r16) * 392 + kc * 64 + ks * 32 + quad * 8);
#pragma unroll
                for (int qt = 0; qt < 2; ++qt) o[dt][qt] = MFMA16(va, pb[qt], o[dt][qt]);
            }
        }
        __builtin_amdgcn_s_setprio(0);
        asm volatile("s_waitcnt lgkmcnt(0)" ::: "memory");
    }
#pragma unroll
    for (int qt = 0; qt < 2; ++qt) {
        float l = lq[qt];
        l += __shfl_xor(l, 16); l += __shfl_xor(l, 32);
        const float inv = __builtin_amdgcn_rcpf(l);
        const int pos = qrow0 + qt * 16 + r16;
#pragma unroll
        for (int dt = 0; dt < 4; ++dt) {
            const f32x4 ov = o[dt][qt] * inv;
            u32x2 ow; ow.x = pk2(ov[0], ov[1]); ow.y = pk2(ov[2], ov[3]);
            *(u32x2*)(Oo + ((size_t)b * SEQ + pos) * 1024 + hq * 64 + dt * 16 + quad * 4) = ow;
        }
    }
    __syncthreads();
}

#define XB_TMO      128
#define XB_XCNT(j)  (256  + 64 * (j))
#define XB_XSUB(j)  (1280 + 64 * (j))
#define XB_XGEN(j)  (2304 + 64 * (j))
#define XB_TOP      3328
#define XB_TOPGEN   3392
#define XCD_BAR_WORDS 3456
#define XB_SPIN_CAP (1u << 18)

__device__ __forceinline__ unsigned xb_ld(unsigned* p)              { return __hip_atomic_load(p, __ATOMIC_RELAXED, __HIP_MEMORY_SCOPE_AGENT); }
__device__ __forceinline__ unsigned xb_add(unsigned* p, unsigned v) { return __hip_atomic_fetch_add(p, v, __ATOMIC_RELAXED, __HIP_MEMORY_SCOPE_AGENT); }
__device__ __forceinline__ unsigned xb_xcc_id() { return (unsigned)__builtin_amdgcn_s_getreg((3 << 11) | 20) & 0xFu; }
#define XB_SPIN(cond, bar) do { unsigned _sp = 0; while (cond) { __builtin_amdgcn_s_sleep(1); \
    if ((++_sp & 255u) == 0u) { if (xb_ld(&(bar)[XB_TMO])) break; if (_sp > XB_SPIN_CAP) { atomicAdd(&(bar)[XB_TMO], 1u); break; } } } } while (0)

struct XcdBarrier {
    unsigned* bar; unsigned x;
    volatile PG8_LAS unsigned* st;
};

__device__ __forceinline__ XcdBarrier xcd_barrier_post(unsigned* bar, volatile PG8_LAS unsigned* st) {
    XcdBarrier b; b.bar = bar; b.x = xb_xcc_id(); b.st = st;
    if (threadIdx.x == 0) (void)xb_add(&bar[XB_XCNT(b.x)], 1u);
    return b;
}
__device__ __forceinline__ void xcd_barrier_complete(unsigned* bar, unsigned x, unsigned& nloc, unsigned& nx) {
    const unsigned G = gridDim.x * gridDim.y * gridDim.z;
    unsigned sum, cnt, mine, sp = 0u;
    for (;;) {
        sum = 0u; cnt = 0u; mine = 0u;
#pragma unroll
        for (unsigned j = 0; j < 16; ++j) { const unsigned c = xb_ld(&bar[XB_XCNT(j)]); sum += c; cnt += (c > 0u) ? 1u : 0u; mine = (j == x) ? c : mine; }
        if (sum == G) break;
        __builtin_amdgcn_s_sleep(1);
        if ((++sp & 255u) == 0u) { if (xb_ld(&bar[XB_TMO])) break; if (sp > XB_SPIN_CAP) { atomicAdd(&bar[XB_TMO], 1u); break; } }
    }
    nloc = mine > 0u ? mine : 1u; nx = cnt > 0u ? cnt : 1u;
}

__device__ __forceinline__ void xcd_barrier(const XcdBarrier& b) {
    asm volatile("s_waitcnt vmcnt(0)" ::: "memory");
    __syncthreads();
    if (threadIdx.x == 0) {
        unsigned* bar = b.bar;
        __builtin_amdgcn_s_waitcnt(0);
        unsigned nloc = b.st[0], nx = b.st[1];
        if (nloc == 0u) { xcd_barrier_complete(bar, b.x, nloc, nx); b.st[0] = nloc; b.st[1] = nx; }
        const unsigned old = xb_add(&bar[XB_XSUB(b.x)], 1u);
        const unsigned gen = old / nloc;
        if (old + 1u == (gen + 1u) * nloc) {
            __builtin_amdgcn_fence(__ATOMIC_RELEASE, "agent");
            asm volatile("s_waitcnt vmcnt(0)" ::: "memory");
            const unsigned og = xb_add(&bar[XB_TOP], 1u);
            const unsigned tg = og / nx;
            if (og + 1u == (tg + 1u) * nx) xb_add(&bar[XB_TOPGEN], 1u);
            else XB_SPIN(xb_ld(&bar[XB_TOPGEN]) == tg, bar);
            __builtin_amdgcn_fence(__ATOMIC_ACQUIRE, "agent");
            xb_add(&bar[XB_XGEN(b.x)], 1u);
            asm volatile("s_waitcnt vmcnt(0)" ::: "memory");
        } else {
            XB_SPIN(xb_ld(&bar[XB_XGEN(b.x)]) == gen, bar);
            __builtin_amdgcn_fence(__ATOMIC_ACQUIRE, "agent");
            asm volatile("s_waitcnt vmcnt(0)" ::: "memory");
        }
    }
    __syncthreads();
}


__global__ void __launch_bounds__(512, 2) fwd_kernel(Prm P0) {
    extern __shared__ __attribute__((aligned(16))) unsigned char lds[];
    cg::grid_group grid = cg::this_grid();
    const int G = gridDim.x, bid = blockIdx.x;
    const XcdBarrier xb = [&]() {
    const Prm& P = P0;
    unsigned char* ws = P.ws;
    unsigned* barw = (unsigned*)(ws + WS_BAR);
    volatile PG8_LAS unsigned* xst = (volatile PG8_LAS unsigned*)((PG8_LAS unsigned char*)lds + (LDS_BYTES - 16));
    if (threadIdx.x == 0) { xst[0] = 0u; xst[1] = 0u; }
    const XcdBarrier xb0 = xcd_barrier_post(barw, xst);
    if (P.x == nullptr) grid.sync();
    prep_phase(P, lds);
    xcd_barrier(xb0);
    return xb0;
    }();
    typedef const __attribute__((address_space(4))) Prm* KPrm;
    const KPrm kp0 = (KPrm)__builtin_amdgcn_kernarg_segment_ptr();
    for (int ph = 0; ph < 36; ++ph) {
        KPrm kp = kp0; asm volatile("" : "+s"(kp));
        Prm P;
        P.x = kp->x; P.norm_g = kp->norm_g; P.rec_w_in = kp->rec_w_in; P.rec_conv_w = kp->rec_conv_w; P.rec_conv_b = kp->rec_conv_b;
        P.rg_w_r = kp->rg_w_r; P.rg_b_r = kp->rg_b_r; P.rg_w_i = kp->rg_w_i; P.rg_b_i = kp->rg_b_i; P.rg_lambda = kp->rg_lambda;
        P.lb_logits = kp->lb_logits; P.hgrn_norm_g = kp->hgrn_norm_g; P.rec_w_out = kp->rec_w_out; P.att_w_qkv = kp->att_w_qkv; P.att_sinks = kp->att_sinks;
        P.att_w_o = kp->att_w_o; P.mlp_w1 = kp->mlp_w1; P.mlp_w2 = kp->mlp_w2; P.out = kp->out; P.ws = kp->ws;
        unsigned char* ws = P.ws;
        const int layer = ph / 9, slot = ph - layer * 9;
        const bool rec = (layer & 1) == 0;
        const int li = layer >> 1;
        const float* g = P.norm_g + (size_t)layer * 4096;
        if (slot == 0 || slot == 4 || slot == 6 || slot == 7) {
            pg8::Gemm gm; Epi E;
            E.Pf = (float*)(ws + WS_PF); E.lbl = (const PG8_LAS float*)((PG8_LAS unsigned char*)lds + 131072);
            if (slot == 0 && rec) {
                const float* lbv = (const float*)(ws + WS_LB) + li * 1024;
                for (int i = threadIdx.x; i < 1024; i += 512) ((PG8_LAS float*)((PG8_LAS unsigned char*)lds + 131072))[i] = lbv[i];
                __syncthreads();
            }
            gm.M = MT;
            if (slot == 0) {
                gm.A = (const bf16_t*)(ws + WS_HB); gm.Bt = (const bf16_t*)(ws + WS_WA); gm.K = 1024;
                gm.N = rec ? 3584 : 1536; E.mode = rec ? 3 : 1; E.O = (bf16_t*)(ws + WS_BIG); E.ldc = rec ? 2560 : 1536;
            } else if (slot == 4) {
                gm.A = (const bf16_t*)P.out; gm.Bt = (const bf16_t*)(ws + WS_WB); gm.K = 1024; gm.N = 1024;
                E.mode = 0; E.O = (bf16_t*)(ws + WS_M); E.ldc = 1024;
            } else if (slot == 6) {
                gm.A = (const bf16_t*)(ws + WS_HB); gm.Bt = (const bf16_t*)(ws + WS_W1); gm.K = 1024; gm.N = 4096;
                E.mode = 2; E.O = (bf16_t*)(ws + WS_BIG); E.ldc = 4096;
            } else {
                gm.A = (const bf16_t*)(ws + WS_BIG); gm.Bt = (const bf16_t*)(ws + WS_W2); gm.K = 4096; gm.N = 1024;
                E.mode = 0; E.O = (bf16_t*)(ws + WS_M); E.ldc = 1024;
            }
            pg8::StaticOrder S; S.init(gm.M, gm.N, G, bid);
            pg8::gemm_phase<Epi, pg8::StaticOrder>((PG8_LAS unsigned char*)lds, gm, S, E);
            if (slot == 0) { __syncthreads(); if (G >= 256) { if (bid >= 128) conv_mlp(P, layer, lds, bid - 128, G - 128); } else conv_mlp(P, layer, lds, bid, G); }
        } else if (slot == 1) {
            if (rec) {
                for (int it = bid; it < 2048; it += G) hgrn_pre(P, it, lds);
                rg_loop<1>(P, li, bid & 3, bid >> 2, G >> 2, lds);
            } else {
                for (int k = 0; k * G < 1024; ++k) { const int it = (G == 256) ? bid * 4 + k : bid + k * G; if (it < 1024) att_item(P, li, it, lds); }
            }
        } else if (slot == 2) {
            if (!rec) continue;
            if (bid < 64) hgrn_seq(P, bid, lds);
            else rg_loop<2>(P, li, (bid - 64) & 3, (bid - 64) >> 2, (G - 64) >> 2, lds);
        } else if (slot == 3) {
            if (!rec) continue;
            hgrn_finish(P, li);
        } else if (slot == 5) {
            resnorm_phase((const bf16_t*)(ws + WS_M), (bf16_t*)(ws + WS_HB), (float*)(ws + WS_RS), g + 1024, nullptr);
        } else {
            resnorm_phase((const bf16_t*)(ws + WS_M), (bf16_t*)(ws + WS_HB), (float*)(ws + WS_RS), g + 3072, layer == 3 ? P.out : nullptr);
            if (layer < 3) conv_layer(P, layer + 1, lds);
        }
        xcd_barrier(xb);
    }
}

extern "C" void kernel_launch(void* const* d_in, const int* in_sizes, int n_in, void* d_out, int out_size, void* d_ws, size_t ws_size, hipStream_t stream) {
    static int grid_blocks = 0;
    if (!grid_blocks) {
        int dev = 0, cus = 0, per_cu = 0;
        hipGetDevice(&dev);
        hipDeviceGetAttribute(&cus, hipDeviceAttributeMultiprocessorCount, dev);
        hipFuncSetAttribute((const void*)fwd_kernel, hipFuncAttributeMaxDynamicSharedMemorySize, LDS_BYTES);
        hipOccupancyMaxActiveBlocksPerMultiprocessor(&per_cu, (const void*)fwd_kernel, 512, LDS_BYTES);
        if (per_cu < 1) per_cu = 1;
        grid_blocks = cus * 1;
        if (ws_size < WS_END) fprintf(stderr, "kernel_launch: workspace too small: %zu < %zu\n", ws_size, (size_t)WS_END);
        (void)hipGetLastError();
    }
    Prm p{};
    p.x = (const float*)d_in[0]; p.norm_g = (const float*)d_in[1]; p.rec_w_in = (const float*)d_in[2]; p.rec_conv_w = (const float*)d_in[3];
    p.rec_conv_b = (const float*)d_in[4]; p.rg_w_r = (const float*)d_in[5]; p.rg_b_r = (const float*)d_in[6]; p.rg_w_i = (const float*)d_in[7];
    p.rg_b_i = (const float*)d_in[8]; p.rg_lambda = (const float*)d_in[9]; p.lb_logits = (const float*)d_in[10]; p.hgrn_norm_g = (const float*)d_in[11];
    p.rec_w_out = (const float*)d_in[12]; p.att_w_qkv = (const float*)d_in[13]; p.att_sinks = (const float*)d_in[14]; p.att_w_o = (const float*)d_in[15];
    p.mlp_w1 = (const float*)d_in[16]; p.mlp_w2 = (const float*)d_in[17];
    p.out = (float*)d_out; p.ws = (unsigned char*)d_ws;
    (void)hipMemsetAsync((char*)d_ws + WS_BAR, 0, 16384 + 4096, stream);
    void* args[] = {&p};
    hipError_t e = hipLaunchCooperativeKernel((const void*)fwd_kernel, dim3(grid_blocks), dim3(512), args, LDS_BYTES, stream);
    if (e != hipSuccess) fprintf(stderr, "cooperative launch failed: %s (grid %d)\n", hipGetErrorString(e), grid_blocks);
}
```
